# Optimizing an MI355X kernel written in HIP

```python
import math
import jax
import jax.numpy as jnp
from jax import lax
import numpy as np

D_MODEL = 1024
BATCH = 8
SEQ = 4096
DEPTH = 4

MEM_LEN = 256
HEAD_DIM = 64
N_BRANCH = 4
BRANCH_WIDTH = D_MODEL // N_BRANCH
FOX_HEADS = BRANCH_WIDTH // HEAD_DIM
DSA_HEADS = BRANCH_WIDTH // HEAD_DIM
IDX_HEADS = 8
IDX_DIM = 32
IDX_TOPK_MAX = 256
DIFF_HEADS = BRANCH_WIDTH // HEAD_DIM
DIFF_QK_DIM = HEAD_DIM // 2
DIFF_V_DIM = HEAD_DIM
MEM_HEADS = BRANCH_WIDTH // HEAD_DIM
FFN_HIDDEN = -(-8 * D_MODEL // (3 * 256)) * 256
ROPE_THETA = 500000.0
ROPE_FRACTION = 4
Q_BLOCK = 128
NORM_EPS = 1e-6

IN_SPLITS = (
    FOX_HEADS * HEAD_DIM, FOX_HEADS * HEAD_DIM, FOX_HEADS * HEAD_DIM, FOX_HEADS,
    DSA_HEADS * HEAD_DIM, HEAD_DIM, HEAD_DIM,
    IDX_HEADS * IDX_DIM, IDX_DIM, IDX_HEADS,
    DIFF_HEADS * 2 * DIFF_QK_DIM, DIFF_HEADS * 2 * DIFF_QK_DIM, DIFF_HEADS * DIFF_V_DIM,
    MEM_HEADS * HEAD_DIM,
)
IN_COLS = sum(IN_SPLITS)

kernel_name = "hybrid_fox_dsa_diff_memory_block"

F32 = jnp.float32


def rms_norm(x, g):
    xf = x.astype(F32)
    y = xf * lax.rsqrt(jnp.mean(xf * xf, axis=-1, keepdims=True) + NORM_EPS)
    return (y * g.astype(F32)).astype(x.dtype)


def rope_tables(positions, rot_dim):
    inv_freq = ROPE_THETA ** (-jnp.arange(0, rot_dim, 2, dtype=F32) / rot_dim)
    ang = positions.astype(F32)[..., None] * inv_freq
    return jnp.cos(ang)[:, :, None, :], jnp.sin(ang)[:, :, None, :]


def apply_partial_rope(x, cos, sin):
    half = cos.shape[-1]
    xf = x.astype(F32)
    x1, x2, rest = xf[..., :half], xf[..., half:2 * half], xf[..., 2 * half:]
    out = jnp.concatenate([x1 * cos - x2 * sin, x2 * cos + x1 * sin, rest], axis=-1)
    return out.astype(x.dtype)


def _to_blocks(a):
    b, s = a.shape[0], a.shape[1]
    return jnp.swapaxes(a.reshape(b, s // Q_BLOCK, Q_BLOCK, *a.shape[2:]), 0, 1)


def _from_blocks(a):
    nb, b, qb = a.shape[0], a.shape[1], a.shape[2]
    return jnp.swapaxes(a, 0, 1).reshape(b, nb * qb, *a.shape[3:])


def _query_positions(blk):
    return blk * Q_BLOCK + jnp.arange(Q_BLOCK)


def _causal_mask(blk, n_keys):
    return jnp.arange(n_keys)[None, :] <= _query_positions(blk)[:, None]


def forgetting_attention(q, k, v, f_logit):
    n_keys = k.shape[1]
    cum = jnp.cumsum(jax.nn.log_sigmoid(f_logit.astype(F32)), axis=1)
    cum_k = jnp.swapaxes(cum, 1, 2)
    scale = HEAD_DIM ** -0.5

    def block(args):
        qb, cb, blk = args
        s = jnp.einsum('bqhd,bkhd->bhqk', qb, k).astype(F32) * scale
        s = s + jnp.swapaxes(cb, 1, 2)[..., None] - cum_k[:, :, None, :]
        s = jnp.where(_causal_mask(blk, n_keys), s, -jnp.inf)
        p = jax.nn.softmax(s, axis=-1)
        return jnp.einsum('bhqk,bkhd->bqhd', p.astype(v.dtype), v)

    nb = q.shape[1] // Q_BLOCK
    out = lax.map(block, (_to_blocks(q), _to_blocks(cum), jnp.arange(nb)))
    return _from_blocks(out)


def dsa_attention(q, k, v, q_idx, k_idx, w_idx):
    n_keys = k.shape[1]
    top_k = min(IDX_TOPK_MAX, n_keys // 4)
    w_idx = w_idx.astype(F32) * IDX_HEADS ** -0.5
    scale = HEAD_DIM ** -0.5
    gather = jax.vmap(lambda kk, ii: kk[ii])

    def block(args):
        qb, qib, wb, blk = args
        rel = jax.nn.relu(jnp.einsum('bqhd,bkd->bqhk', qib, k_idx).astype(F32) * IDX_DIM ** -0.5)
        score = jnp.einsum('bqhk,bqh->bqk', rel, wb)
        score = jnp.where(_causal_mask(blk, n_keys)[None], score, -jnp.inf)
        _, sel = lax.top_k(score, top_k)
        k_sel = gather(k, sel)
        v_sel = gather(v, sel)
        valid = sel <= _query_positions(blk)[None, :, None]
        s = jnp.einsum('bqhd,bqkd->bhqk', qb, k_sel).astype(F32) * scale
        s = jnp.where(valid[:, None], s, -jnp.inf)
        p = jax.nn.softmax(s, axis=-1)
        return jnp.einsum('bhqk,bqkd->bqhd', p.astype(v.dtype), v_sel)

    nb = q.shape[1] // Q_BLOCK
    out = lax.map(block, (_to_blocks(q), _to_blocks(q_idx), _to_blocks(w_idx), jnp.arange(nb)))
    return _from_blocks(out)


def differential_attention(q, k, v, lam, subln_g, lambda_init):
    n_keys = k.shape[1]
    scale = DIFF_QK_DIM ** -0.5

    def block(args):
        qb, blk = args
        s = jnp.einsum('bqhmd,bkhmd->bmhqk', qb, k).astype(F32) * scale
        s = jnp.where(_causal_mask(blk, n_keys), s, -jnp.inf)
        p = jax.nn.softmax(s, axis=-1)
        a = p[:, 0] - lam * p[:, 1]
        return jnp.einsum('bhqk,bkhd->bqhd', a.astype(v.dtype), v)

    nb = q.shape[1] // Q_BLOCK
    out = _from_blocks(lax.map(block, (_to_blocks(q), jnp.arange(nb))))
    return rms_norm(out, subln_g) * (1.0 - lambda_init)


def memory_attention(q, mem, g, w_kv):
    b, m = mem.shape[0], mem.shape[1]
    kv = (rms_norm(mem, g) @ w_kv).reshape(b, m, 2, MEM_HEADS, HEAD_DIM)
    k, v = kv[:, :, 0], kv[:, :, 1]
    s = jnp.einsum('bshd,bmhd->bhsm', q, k).astype(F32) * HEAD_DIM ** -0.5
    p = jax.nn.softmax(s, axis=-1)
    return jnp.einsum('bhsm,bmhd->bshd', p.astype(v.dtype), v)


def setup_inputs(seed: int = 0) -> dict:
    key = jax.random.key(seed)
    ks = jax.random.split(key, 20)

    def nrm(k, shape, fan_in):
        return jax.random.normal(k, shape, F32) * fan_in ** -0.5

    def gain(k, shape):
        return 1.0 + 0.02 * jax.random.normal(k, shape, F32)

    x = jax.random.normal(ks[0], (BATCH, SEQ, D_MODEL), F32)
    mem = jax.random.normal(ks[1], (BATCH, MEM_LEN, D_MODEL), F32)
    positions = (jax.random.randint(ks[2], (BATCH, 1), 0, 1024, dtype=jnp.int32)
                 + jnp.arange(SEQ, dtype=jnp.int32)[None, :])
    return {
        "x": x,
        "mem": mem,
        "positions": positions,
        "norm_mix_g": gain(ks[3], (DEPTH, D_MODEL)),
        "w_in": nrm(ks[4], (DEPTH, D_MODEL, IN_COLS), D_MODEL),
        "b_forget": jax.random.uniform(ks[5], (DEPTH, FOX_HEADS), F32, minval=2.0, maxval=5.0),
        "diff_lambda": 0.1 * jax.random.normal(ks[6], (DEPTH, 4, DIFF_QK_DIM), F32),
        "diff_subln_g": gain(ks[7], (DEPTH, DIFF_V_DIM)),
        "norm_mem_g": gain(ks[8], (DEPTH, D_MODEL)),
        "w_mem_kv": nrm(ks[9], (DEPTH, D_MODEL, 2 * MEM_HEADS * HEAD_DIM), D_MODEL),
        "w_branch": nrm(ks[10], (DEPTH, N_BRANCH, BRANCH_WIDTH, D_MODEL), BRANCH_WIDTH),
        "w_gate": nrm(ks[11], (DEPTH, D_MODEL, N_BRANCH * D_MODEL), D_MODEL),
        "b_gate": 0.02 * jax.random.normal(ks[12], (DEPTH, N_BRANCH * D_MODEL), F32),
        "w_out": nrm(ks[13], (DEPTH, D_MODEL, D_MODEL), D_MODEL),
        "norm_ffn_g": gain(ks[14], (DEPTH, D_MODEL)),
        "w_ffn_in": nrm(ks[15], (DEPTH, D_MODEL, 2 * FFN_HIDDEN), D_MODEL),
        "w_ffn_out": nrm(ks[16], (DEPTH, FFN_HIDDEN, D_MODEL), FFN_HIDDEN),
        "final_norm_g": gain(ks[17], (D_MODEL,)),
    }


def reference(x, mem, positions, norm_mix_g, w_in, b_forget, diff_lambda, diff_subln_g,
              norm_mem_g, w_mem_kv, w_branch, w_gate, b_gate, w_out, norm_ffn_g,
              w_ffn_in, w_ffn_out, final_norm_g):
    b, s = x.shape[0], x.shape[1]
    cos16, sin16 = rope_tables(positions, HEAD_DIM // ROPE_FRACTION)
    cos8, sin8 = rope_tables(positions, DIFF_QK_DIM // ROPE_FRACTION)

    for l in range(DEPTH):
        lambda_init = 0.8 - 0.6 * math.exp(-0.3 * l)
        h = rms_norm(x, norm_mix_g[l])
        z = h @ w_in[l]
        parts = []
        off = 0
        for n in IN_SPLITS:
            parts.append(z[..., off:off + n])
            off += n
        (qa, ka, va, fa, qb, kb, vb, qi, ki, wi, qc, kc, vc, qm) = parts

        o_a = forgetting_attention(qa.reshape(b, s, FOX_HEADS, HEAD_DIM),
                                   ka.reshape(b, s, FOX_HEADS, HEAD_DIM),
                                   va.reshape(b, s, FOX_HEADS, HEAD_DIM),
                                   fa + b_forget[l])

        qb = apply_partial_rope(qb.reshape(b, s, DSA_HEADS, HEAD_DIM), cos16, sin16)
        kb = apply_partial_rope(kb[:, :, None, :], cos16, sin16)[:, :, 0]
        qi = apply_partial_rope(qi.reshape(b, s, IDX_HEADS, IDX_DIM), cos8, sin8)
        ki = apply_partial_rope(ki[:, :, None, :], cos8, sin8)[:, :, 0]
        o_b = dsa_attention(qb, kb, vb, qi, ki, wi)

        qc = apply_partial_rope(qc.reshape(b, s, DIFF_HEADS * 2, DIFF_QK_DIM), cos8, sin8)
        kc = apply_partial_rope(kc.reshape(b, s, DIFF_HEADS * 2, DIFF_QK_DIM), cos8, sin8)
        lam_vec = diff_lambda[l].astype(F32)
        lam = (jnp.exp(jnp.sum(lam_vec[0] * lam_vec[1]))
               - jnp.exp(jnp.sum(lam_vec[2] * lam_vec[3])) + lambda_init)
        o_c = differential_attention(qc.reshape(b, s, DIFF_HEADS, 2, DIFF_QK_DIM),
                                     kc.reshape(b, s, DIFF_HEADS, 2, DIFF_QK_DIM),
                                     vc.reshape(b, s, DIFF_HEADS, DIFF_V_DIM),
                                     lam, diff_subln_g[l], lambda_init)

        o_m = memory_attention(qm.reshape(b, s, MEM_HEADS, HEAD_DIM), mem, norm_mem_g[l], w_mem_kv[l])

        o = jnp.stack([o_a.reshape(b, s, BRANCH_WIDTH), o_b.reshape(b, s, BRANCH_WIDTH),
                       o_c.reshape(b, s, BRANCH_WIDTH), o_m.reshape(b, s, BRANCH_WIDTH)], axis=2)
        y = jnp.einsum('bsnc,ncd->bsnd', o, w_branch[l])
        g = jax.nn.sigmoid(h @ w_gate[l] + b_gate[l]).reshape(b, s, N_BRANCH, D_MODEL)
        x = x + jnp.sum(g * y, axis=2) @ w_out[l]

        h2 = rms_norm(x, norm_ffn_g[l])
        u = h2 @ w_ffn_in[l]
        x = x + (jax.nn.silu(u[..., :FFN_HIDDEN]) * u[..., FFN_HIDDEN:]) @ w_ffn_out[l]

    return rms_norm(x, final_norm_g)
```

```cpp
#include <hip/hip_runtime.h>
#include <cstdint>
#include <cstdio>
#include <cmath>

#ifndef PROBE_DUP
#define PROBE_DUP 0
#endif
#ifndef ATT_DMA_MODES
#define ATT_DMA_MODES 15
#endif
#ifndef MK_ONE_LAUNCH
#define MK_ONE_LAUNCH 1
#endif

#define GAS __attribute__((address_space(1)))
#define LAS __attribute__((address_space(3)))
typedef unsigned short bf16_t;
typedef short bf16x8 __attribute__((ext_vector_type(8)));
typedef short v4i16_t __attribute__((ext_vector_type(4)));
typedef float f32x4 __attribute__((ext_vector_type(4)));
typedef float f32x16 __attribute__((ext_vector_type(16)));
typedef unsigned u32x4 __attribute__((ext_vector_type(4)));
typedef unsigned u32x2 __attribute__((ext_vector_type(2)));
typedef GAS unsigned gu32;

constexpr int NB = 8, SEQ = 4096, T = NB * SEQ, DM = 1024, DEPTH = 4, MEML = 256, FF = 2816, INC = 2476;
constexpr int ZP = 2560;
constexpr float EPS = 1e-6f;
constexpr float LOG2E = 1.4426950408889634f;
constexpr int NTHREADS = 512;

constexpr size_t MiB = 1u << 20;
constexpr size_t OFF_CTL = 0, CTL_BYTES = 256 * 1024;
constexpr size_t ZERO_BYTES = CTL_BYTES;
constexpr size_t OFF_W1T = 2 * MiB;
constexpr size_t OFF_WGT = OFF_W1T + 5 * MiB;
constexpr size_t OFF_WBT = OFF_WGT + 8 * MiB;
constexpr size_t OFF_WOT = OFF_WBT + 2 * MiB;
constexpr size_t OFF_WF1T = OFF_WOT + 2 * MiB;
constexpr size_t OFF_WF2T = OFF_WF1T + 11 * MiB;
constexpr size_t OFF_WMEMT = OFF_WF2T + 6 * MiB;
constexpr size_t OFF_MEMB = OFF_WMEMT + 4 * MiB;
constexpr size_t OFF_MEMKV = OFF_MEMB + 4 * MiB;
constexpr size_t OFF_MISC = OFF_MEMKV + 8 * MiB;
constexpr size_t OFF_CS16 = OFF_MISC + 1 * MiB;
constexpr size_t OFF_CS8 = OFF_CS16 + 2 * MiB;
constexpr size_t OFF_SS = OFF_CS8 + 1 * MiB;
constexpr size_t OFF_FL = OFF_SS + 4 * MiB;
constexpr size_t OFF_CUM = OFF_FL + 1 * MiB;
constexpr size_t OFF_WI = OFF_CUM + 1 * MiB;
constexpr size_t OFF_MASK = OFF_WI + 1 * MiB;
constexpr size_t OFF_X = OFF_MASK + 16 * MiB;
constexpr size_t OFF_XB = OFF_X + 128 * MiB;
constexpr size_t OFF_Z = OFF_XB + 64 * MiB;
constexpr size_t OFF_O = OFF_Z + 160 * MiB;
constexpr size_t WS_END = OFF_O + 64 * MiB;
constexpr size_t OFF_MRG = OFF_Z + 128 * MiB;
constexpr size_t OFF_AF = OFF_Z;
static_assert((size_t)T * FF * 2 <= 224 * MiB, "AF fits Z|O");
static_assert(ZERO_BYTES <= 2 * MiB && WS_END <= 512 * MiB, "workspace map");

constexpr int CW_BAR = 4096;
constexpr int CW_Q = 16384;

constexpr int LDS_MAIN = 131072;
constexpr int LDS_CTL = LDS_MAIN;
constexpr int LDS_BYTES = 132096;

typedef __bf16 bf16pair_t __attribute__((ext_vector_type(2)));
typedef float f32x2 __attribute__((ext_vector_type(2)));
__device__ __forceinline__ unsigned cvt_pk_bf16(float lo, float hi) { unsigned r; asm("v_cvt_pk_bf16_f32 %0, %1, %2" : "=v"(r) : "v"(lo), "v"(hi)); return r; }
__device__ __forceinline__ unsigned cvt_pk_bf16_c(float lo, float hi) { return __builtin_bit_cast(unsigned, __builtin_convertvector((f32x2){lo, hi}, bf16pair_t)); }
__device__ __forceinline__ void st16_wt(void* p, u32x4 v) { *(u32x4*)p = v; }
__device__ __forceinline__ float wave_sum(float v) {
#pragma unroll
    for (int o = 1; o < 64; o <<= 1) v += __shfl_xor(v, o);
    return v;
}
__device__ __forceinline__ float fexp2(float x) { return __builtin_amdgcn_exp2f(x); }

#define XB_TMO      128
#define XB_XCNT(j)  (256  + 64 * (j))
#define XB_XSUB(j)  (1280 + 64 * (j))
#define XB_XGEN(j)  (2304 + 64 * (j))
#define XB_TOP      3328
#define XB_TOPGEN   3392
#define XCD_BAR_WORDS 3456
#define XB_SPIN_CAP (1u << 22)
__device__ __forceinline__ unsigned xb_ld(unsigned* p)              { return __hip_atomic_load(p, __ATOMIC_RELAXED, __HIP_MEMORY_SCOPE_AGENT); }
__device__ __forceinline__ unsigned xb_add(unsigned* p, unsigned v) { return __hip_atomic_fetch_add(p, v, __ATOMIC_RELAXED, __HIP_MEMORY_SCOPE_AGENT); }
__device__ __forceinline__ unsigned xb_xcc_id() { return (unsigned)__builtin_amdgcn_s_getreg((3 << 11) | 20) & 0xFu; }
#define XB_SPIN(cond, bar) do { unsigned _sp = 0; while (cond) { __builtin_amdgcn_s_sleep(1); \
    if ((++_sp & 255u) == 0u) { if (xb_ld(&(bar)[XB_TMO])) break; if (_sp > XB_SPIN_CAP) { atomicAdd(&(bar)[XB_TMO], 1u); break; } } } } while (0)
struct XcdBarrier { unsigned* bar; unsigned x; volatile LAS unsigned* st; };
__device__ __forceinline__ XcdBarrier xcd_barrier_post(unsigned* bar, volatile LAS unsigned* st) {
    XcdBarrier b; b.bar = bar; b.x = xb_xcc_id(); b.st = st;
    if (threadIdx.x == 0) (void)xb_add(&bar[XB_XCNT(b.x)], 1u);
    return b;
}
__device__ __forceinline__ void xcd_barrier_complete(unsigned* bar, unsigned x, unsigned& nloc, unsigned& nx) {
    const unsigned G = gridDim.x * gridDim.y * gridDim.z;
    unsigned sum, cnt, mine, sp = 0u;
    for (;;) {
        sum = 0u; cnt = 0u; mine = 0u;
#pragma unroll
        for (unsigned j = 0; j < 16; ++j) { const unsigned c = xb_ld(&bar[XB_XCNT(j)]); sum += c; cnt += (c > 0u) ? 1u : 0u; mine = (j == x) ? c : mine; }
        if (sum == G) break;
        __builtin_amdgcn_s_sleep(1);
        if ((++sp & 255u) == 0u) { if (xb_ld(&bar[XB_TMO])) break; if (sp > XB_SPIN_CAP) { atomicAdd(&bar[XB_TMO], 1u); break; } }
    }
    nloc = mine > 0u ? mine : 1u; nx = cnt > 0u ? cnt : 1u;
}
__device__ __forceinline__ void xcd_barrier(const XcdBarrier& b, int wid) {
    asm volatile("s_waitcnt vmcnt(0)" ::: "memory");
    __syncthreads();
    int ln0_; asm volatile("v_mbcnt_lo_u32_b32 %0, -1, 0\n\tv_mbcnt_hi_u32_b32 %0, -1, %0" : "=v"(ln0_));
    if (wid == 0 && ln0_ == 0) {
        unsigned* bar = b.bar;
        __builtin_amdgcn_s_waitcnt(0);
        unsigned nloc = b.st[0], nx = b.st[1];
        if (nloc == 0u) { xcd_barrier_complete(bar, b.x, nloc, nx); b.st[0] = nloc; b.st[1] = nx; }
        const unsigned old = xb_add(&bar[XB_XSUB(b.x)], 1u);
        const unsigned gen = old / nloc;
        if (old + 1u == (gen + 1u) * nloc) {
            __builtin_amdgcn_fence(__ATOMIC_RELEASE, "agent");
            asm volatile("s_waitcnt vmcnt(0)" ::: "memory");
            const unsigned og = xb_add(&bar[XB_TOP], 1u);
            const unsigned tg = og / nx;
            if (og + 1u == (tg + 1u) * nx) xb_add(&bar[XB_TOPGEN], 1u);
            else XB_SPIN(xb_ld(&bar[XB_TOPGEN]) == tg, bar);
            __builtin_amdgcn_fence(__ATOMIC_ACQUIRE, "agent");
            xb_add(&bar[XB_XGEN(b.x)], 1u);
            asm volatile("s_waitcnt vmcnt(0)" ::: "memory");
        } else {
            XB_SPIN(xb_ld(&bar[XB_XGEN(b.x)]) == gen, bar);
            __builtin_amdgcn_fence(__ATOMIC_ACQUIRE, "agent");
            asm volatile("s_waitcnt vmcnt(0)" ::: "memory");
        }
    }
    __syncthreads();
}

struct Params {
    const float* in[18]; float* out; unsigned char* ws; int s_lo, s_hi;
};
struct Ctx {
    const float *x, *mem; const int* pos;
    const float *norm_mix_g, *w_in, *b_forget, *diff_lambda, *diff_subln_g, *norm_mem_g, *w_mem_kv, *w_branch, *w_gate, *b_gate, *w_out, *norm_ffn_g, *w_ffn_in, *w_ffn_out, *final_norm_g;
    float* out; unsigned char* ws; LAS unsigned char* lds; int tid, lane, wid; int nblk, blk;
};
#define WSP(type, off) ((type*)(c.ws + (off)))
#define PHASE_CTX(c0) Ctx c = (c0); { int wv_ = c.wid; asm volatile("" : "+s"(wv_)); int ln_; asm volatile("v_mbcnt_lo_u32_b32 %0, -1, 0\n\tv_mbcnt_hi_u32_b32 %0, -1, %0" : "=v"(ln_)); \
    c.wid = wv_; c.lane = ln_; c.tid = wv_ * 64 + ln_; \
    GAS unsigned char* w_ = (GAS unsigned char*)c.ws; asm volatile("" : "+s"(w_)); c.ws = (unsigned char*)w_; \
      \
    const __attribute__((address_space(4))) Params* kp_ = (const __attribute__((address_space(4))) Params*)__builtin_amdgcn_kernarg_segment_ptr(); asm volatile("" : "+s"(kp_)); \
    c.x = kp_->in[0]; c.mem = kp_->in[1]; c.pos = (const int*)kp_->in[2]; c.norm_mix_g = kp_->in[3]; c.w_in = kp_->in[4]; c.b_forget = kp_->in[5]; c.diff_lambda = kp_->in[6]; c.diff_subln_g = kp_->in[7]; \
    c.norm_mem_g = kp_->in[8]; c.w_mem_kv = kp_->in[9]; c.w_branch = kp_->in[10]; c.w_gate = kp_->in[11]; c.b_gate = kp_->in[12]; c.w_out = kp_->in[13]; c.norm_ffn_g = kp_->in[14]; c.w_ffn_in = kp_->in[15]; \
    c.w_ffn_out = kp_->in[16]; c.final_norm_g = kp_->in[17]; c.out = kp_->out; }

__device__ __forceinline__ int q_next(const Ctx& c, int qid) {
    volatile LAS unsigned* slot = (volatile LAS unsigned*)(c.lds + LDS_CTL + 64);
    __syncthreads();
    if (c.tid == 0) slot[0] = __hip_atomic_fetch_add(WSP(unsigned, OFF_CTL) + CW_Q + 64 * qid, 1u, __ATOMIC_RELAXED, __HIP_MEMORY_SCOPE_AGENT);
    __syncthreads();
    return (int)slot[0];
}

__device__ __forceinline__ int sw_off(int row, int ch) { return row * 128 + ((ch ^ ((row >> 1) & 7)) << 4); }
__device__ __forceinline__ void gemm_tile(f32x4 (&acc)[4][2], const bf16_t* A, int lda, const bf16_t* Bt, int ldb, int K, LAS unsigned char* lds, int tid) {
    const int wid = tid >> 6, lane = tid & 63, fr = lane & 15, fq = lane >> 4, wr = wid >> 2, wc = wid & 3;
    const int srow = tid >> 3, sch = tid & 7;
    const bf16_t* ga = A + (size_t)srow * lda + sch * 8;
    const bf16_t* gb = Bt + (size_t)srow * ldb + sch * 8;
    const size_t a64 = (size_t)64 * lda, b64 = (size_t)64 * ldb;
    const int so0 = sw_off(srow, sch), so1 = sw_off(srow + 64, sch);
    u32x4 ra0 = *(const u32x4*)ga, ra1 = *(const u32x4*)(ga + a64), rb0 = *(const u32x4*)gb, rb1 = *(const u32x4*)(gb + b64);
    *(LAS u32x4*)(lds + so0) = ra0; *(LAS u32x4*)(lds + so1) = ra1; *(LAS u32x4*)(lds + 16384 + so0) = rb0; *(LAS u32x4*)(lds + 16384 + so1) = rb1;
    __syncthreads();
    const int nk = K >> 6;
    for (int kt = 0; kt < nk; ++kt) {
        const int cur = (kt & 1) * 32768, nxt = cur ^ 32768;
        const bool more = kt + 1 < nk;
        if (more) { const int ko = (kt + 1) * 64; ra0 = *(const u32x4*)(ga + ko); ra1 = *(const u32x4*)(ga + a64 + ko); rb0 = *(const u32x4*)(gb + ko); rb1 = *(const u32x4*)(gb + b64 + ko); }
#pragma unroll
        for (int kk = 0; kk < 2; ++kk) {
            bf16x8 af[4], bv[2];
#pragma unroll
            for (int m = 0; m < 4; ++m) af[m] = *(const LAS bf16x8*)(lds + cur + sw_off(wr * 64 + m * 16 + fr, kk * 4 + fq));
#pragma unroll
            for (int n = 0; n < 2; ++n) bv[n] = *(const LAS bf16x8*)(lds + cur + 16384 + sw_off(wc * 32 + n * 16 + fr, kk * 4 + fq));
#pragma unroll
            for (int m = 0; m < 4; ++m)
#pragma unroll
                for (int n = 0; n < 2; ++n) acc[m][n] = __builtin_amdgcn_mfma_f32_16x16x32_bf16(bv[n], af[m], acc[m][n], 0, 0, 0);
        }
        if (more) { *(LAS u32x4*)(lds + nxt + so0) = ra0; *(LAS u32x4*)(lds + nxt + so1) = ra1; *(LAS u32x4*)(lds + nxt + 16384 + so0) = rb0; *(LAS u32x4*)(lds + nxt + 16384 + so1) = rb1; }
        __syncthreads();
    }
}
__device__ __forceinline__ void acc_zero(f32x4 (&acc)[4][2]) {
#pragma unroll
    for (int m = 0; m < 4; ++m)
#pragma unroll
        for (int n = 0; n < 2; ++n) acc[m][n] = (f32x4){0.f, 0.f, 0.f, 0.f};
}

namespace pg8 {
#define PG8_LAS __attribute__((address_space(3)))
typedef unsigned short bf16_t;
typedef short bf16x8 __attribute__((ext_vector_type(8)));
typedef float f32x4 __attribute__((ext_vector_type(4)));
typedef unsigned u32x4 __attribute__((ext_vector_type(4)));
constexpr int BM = 256, BK = 64, HALF = 128, HTB = HALF * BK * 2  , STAGE_BYTES = 8 * HTB, NXCD = 8, WGM = 8;

__host__ __device__ __forceinline__ int lds_byte(int r, int c) { const int st = (r >> 4) * 2 + (c >> 5), rr = r & 15, cc = c & 31, ob = rr * 64 + cc * 2; return st * 1024 + (ob ^ (((ob >> 9) & 1) << 5)); }
__host__ __device__ __forceinline__ void stage_rc(int b, int& R, int& C) { const int st = b / 1024, sb = b % 1024, swz = sb ^ (((sb >> 9) & 1) << 5); R = (st >> 1) * 16 + swz / 64; C = (st & 1) * 32 + (swz % 64) / 2; }
__host__ __device__ __forceinline__ int perm32(int rho) { const int n = rho >> 4, i = rho & 15; return 8 * (i >> 2) + 4 * n + (i & 3); }

struct Unit { int pm, pn; };
struct Gemm { const bf16_t* A; const bf16_t* Bt; int M, N, K; };

struct StaticOrder {
    int nM, nN, nwg, G, c;
    __host__ __device__ void init(int M, int N, int G_, int c_) { nM = M / BM; nN = N / BM; nwg = nM * nN; G = G_; c = c_; }
    __host__ __device__ bool next(int i, Unit& u) const {
        const long L = (long)i * G + c; if (L >= nwg) return false;
        int wgid = (int)L; { const int q = nwg / NXCD, r = nwg % NXCD, xcd = wgid % NXCD, off = wgid / NXCD; wgid = (xcd < r ? xcd * (q + 1) : r * (q + 1) + (xcd - r) * q) + off; }
        const int nig = WGM * nN, gid = wgid / nig, fm = gid * WGM, gsz = (nM - fm) < WGM ? (nM - fm) : WGM;
        u.pm = fm + ((wgid % nig) % gsz); u.pn = (wgid % nig) / gsz; return true;
    }
    __device__ __forceinline__ void a_ready(const Unit&) const {}
    __device__ __forceinline__ void done(const Unit&) const {}
};

template <class Epi, class Sched, bool ALIGN_EPI = false, bool SP2 = false>
__device__ __forceinline__ void gemm_phase(PG8_LAS unsigned char* lds, const Gemm g, const Sched& S, const Epi& E, const int tid) {
    const int wid = __builtin_amdgcn_readfirstlane(tid >> 6), lane = tid & 63, wr = wid >> 2, wc = wid & 3, fr = lane & 15, fq = lane >> 4;
    const int K = g.K, nt = K / BK;
    unsigned voffA[2], voffB[2];
#pragma unroll
    for (int i = 0; i < 2; ++i) { int R, C; stage_rc(tid * 16 + i * 8192, R, C); const int Rb = Epi::PERM ? ((R & ~31) + perm32(R & 31)) : R;
        voffA[i] = (unsigned)(R * K + C) * 2u; voffB[i] = (unsigned)(Rb * K + C) * 2u; }
    const size_t kstep = (size_t)(BK * 2);
    const size_t hstep = (size_t)HALF * K * 2;
    const size_t tstep = 2 * hstep;
    const unsigned ldsw = (unsigned)wid * 1024u;
    const int aoff = lds_byte(wr * 64 + fr, fq * 8), boff = lds_byte(wc * 32 + fr, fq * 8);
#define PG8_SA(b, h) (((b) * 2 + (h)) * HTB)
#define PG8_SB(b, h) ((4 + (b) * 2 + (h)) * HTB)
#define PG8_STAGE(bufoff, gbase, voff) do { _Pragma("unroll") for (int _i = 0; _i < 2; ++_i) \
        __builtin_amdgcn_global_load_lds((const unsigned*)((const char*)(gbase) + (voff)[_i]), (PG8_LAS unsigned*)(lds + (bufoff) + ldsw + _i * 8192), 16, 0, 0); } while (0)
#define PG8_LDA(dst, b, h) do { _Pragma("unroll") for (int m = 0; m < 4; ++m) _Pragma("unroll") for (int k = 0; k < 2; ++k) dst[m][k] = *(const PG8_LAS bf16x8*)(lds + PG8_SA(b, h) + aoff + m * 2048 + k * 1024); } while (0)
#define PG8_LDB(dst, b, h) do { _Pragma("unroll") for (int n = 0; n < 2; ++n) _Pragma("unroll") for (int k = 0; k < 2; ++k) dst[n][k] = *(const PG8_LAS bf16x8*)(lds + PG8_SB(b, h) + boff + n * 2048 + k * 1024); } while (0)
#define PG8_MMA(ai, bj, At, Bt) do { __builtin_amdgcn_s_setprio(1); _Pragma("unroll") for (int m = 0; m < 4; ++m) _Pragma("unroll") for (int n = 0; n < 2; ++n) _Pragma("unroll") for (int k = 0; k < 2; ++k) \
        acc[ai][bj][m][n] = __builtin_amdgcn_mfma_f32_16x16x32_bf16(Bt[n][k], At[m][k], acc[ai][bj][m][n], 0, 0, 0); __builtin_amdgcn_s_setprio(0); } while (0)
#define PG8_WAIT_V(n) asm volatile("s_waitcnt vmcnt(" #n ")" ::: "memory")
#define PG8_WAIT_L(n) asm volatile("s_waitcnt lgkmcnt(" #n ")" ::: "memory")
#define PG8_BAR __builtin_amdgcn_s_barrier()
#define PG8_SCHED __builtin_amdgcn_sched_barrier(0)
    Unit cur, nxt; int ui = 0;
    if (!S.next(0, cur)) return;
    f32x4 acc[2][2][4][2];
#pragma unroll
    for (int a = 0; a < 2; ++a)
#pragma unroll
        for (int b = 0; b < 2; ++b)
#pragma unroll
            for (int m = 0; m < 4; ++m)
#pragma unroll
                for (int n = 0; n < 2; ++n) acc[a][b][m][n] = (f32x4){0.f, 0.f, 0.f, 0.f};
    bf16x8 At[4][2], B0[2][2], B1[2][2];
    const char* cA = (const char*)g.A + (size_t)cur.pm * tstep; const char* cB = (const char*)g.Bt + (size_t)cur.pn * tstep;
    S.a_ready(cur);
    if constexpr (SP2) {
        PG8_STAGE(PG8_SB(0, 0), cB, voffB); PG8_STAGE(PG8_SB(0, 1), cB + hstep, voffB); PG8_STAGE(PG8_SA(0, 0), cA, voffA); PG8_STAGE(PG8_SA(0, 1), cA + hstep, voffA);
        if (wr == 1) PG8_BAR;
        PG8_WAIT_V(2); PG8_BAR;
        PG8_STAGE(PG8_SB(1, 0), cB + kstep, voffB); PG8_STAGE(PG8_SA(1, 0), cA + kstep, voffA); PG8_STAGE(PG8_SB(1, 1), cB + hstep + kstep, voffB);
        PG8_WAIT_V(6); PG8_BAR;
    } else {
        PG8_STAGE(PG8_SB(0, 0), cB, voffB); PG8_STAGE(PG8_SA(0, 0), cA, voffA); PG8_STAGE(PG8_SB(0, 1), cB + hstep, voffB); PG8_STAGE(PG8_SA(0, 1), cA + hstep, voffA);
        if (wr == 1) PG8_BAR;
        PG8_WAIT_V(4); PG8_BAR;
        PG8_STAGE(PG8_SB(1, 0), cB + kstep, voffB); PG8_STAGE(PG8_SA(1, 0), cA + kstep, voffA); PG8_STAGE(PG8_SB(1, 1), cB + hstep + kstep, voffB);
        PG8_WAIT_V(6); PG8_BAR;
    }
    for (;;) {
        const bool has_next = S.next(ui + 1, nxt);
        const char* nA = has_next ? (const char*)g.A + (size_t)nxt.pm * tstep : cA; const char* nB = has_next ? (const char*)g.Bt + (size_t)nxt.pn * tstep : cB;
        for (int t = 0; t < nt; t += 2) {
            const bool last = (t == nt - 2);
            const char* a1 = cA + (size_t)(t + 1) * kstep;
            const char* a2 = last ? nA : cA + (size_t)(t + 2) * kstep; const char* b2 = last ? nB : cB + (size_t)(t + 2) * kstep;
            const char* a3 = a2 + kstep; const char* b3 = b2 + kstep;
            if (last && has_next) S.a_ready(nxt);
            if constexpr (SP2) {
            PG8_LDB(B0, 0, 0); PG8_LDB(B1, 0, 1); PG8_SCHED; PG8_LDA(At, 0, 0); PG8_STAGE(PG8_SA(1, 1), a1 + hstep, voffA);
            PG8_WAIT_V(8); PG8_WAIT_L(0); PG8_BAR; PG8_MMA(0, 0, At, B0); PG8_MMA(0, 1, At, B1); PG8_BAR; PG8_SCHED;
            PG8_LDA(At, 0, 1); PG8_STAGE(PG8_SB(0, 0), b2, voffB); PG8_STAGE(PG8_SB(0, 1), b2 + hstep, voffB); PG8_STAGE(PG8_SA(0, 0), a2, voffA);
            PG8_WAIT_V(8); PG8_WAIT_L(0); PG8_BAR; PG8_MMA(1, 0, At, B0); PG8_MMA(1, 1, At, B1); PG8_BAR; PG8_SCHED;
            PG8_LDB(B0, 1, 0); PG8_LDB(B1, 1, 1); PG8_SCHED; PG8_LDA(At, 1, 0); PG8_STAGE(PG8_SA(0, 1), a2 + hstep, voffA);
            PG8_WAIT_V(8); PG8_WAIT_L(0); PG8_BAR; PG8_MMA(0, 0, At, B0); PG8_MMA(0, 1, At, B1); PG8_BAR; PG8_SCHED;
            PG8_LDA(At, 1, 1); PG8_STAGE(PG8_SB(1, 0), b3, voffB); PG8_STAGE(PG8_SB(1, 1), b3 + hstep, voffB); PG8_STAGE(PG8_SA(1, 0), a3, voffA);
            PG8_WAIT_V(8); PG8_WAIT_L(0); PG8_BAR; PG8_MMA(1, 0, At, B0); PG8_MMA(1, 1, At, B1); PG8_BAR; PG8_SCHED;
            } else {
            PG8_LDB(B0, 0, 0); PG8_SCHED; PG8_LDA(At, 0, 0); PG8_STAGE(PG8_SA(1, 1), a1 + hstep, voffA);
            PG8_WAIT_L(8); PG8_BAR; PG8_WAIT_L(0); PG8_MMA(0, 0, At, B0); PG8_BAR; PG8_SCHED;
            PG8_LDB(B1, 0, 1); PG8_STAGE(PG8_SB(0, 0), b2, voffB);
            PG8_BAR; PG8_WAIT_L(0); PG8_MMA(0, 1, At, B1); PG8_BAR;
            PG8_LDA(At, 0, 1); PG8_STAGE(PG8_SA(0, 0), a2, voffA);
            PG8_BAR; PG8_WAIT_L(0); PG8_MMA(1, 0, At, B0); PG8_BAR; PG8_SCHED;
            PG8_STAGE(PG8_SB(0, 1), b2 + hstep, voffB);
            PG8_WAIT_V(6); PG8_BAR; PG8_MMA(1, 1, At, B1); PG8_BAR;
            PG8_LDB(B0, 1, 0); PG8_SCHED; PG8_LDA(At, 1, 0); PG8_STAGE(PG8_SA(0, 1), a2 + hstep, voffA);
            PG8_WAIT_L(8); PG8_BAR; PG8_WAIT_L(0); PG8_MMA(0, 0, At, B0); PG8_BAR; PG8_SCHED;
            PG8_LDB(B1, 1, 1); PG8_STAGE(PG8_SB(1, 0), b3, voffB);
            PG8_BAR; PG8_WAIT_L(0); PG8_MMA(0, 1, At, B1); PG8_BAR;
            PG8_LDA(At, 1, 1); PG8_STAGE(PG8_SA(1, 0), a3, voffA);
            PG8_BAR; PG8_WAIT_L(0); PG8_MMA(1, 0, At, B0); PG8_BAR; PG8_SCHED;
            PG8_STAGE(PG8_SB(1, 1), b3 + hstep, voffB);
            PG8_WAIT_V(6); PG8_BAR; PG8_MMA(1, 1, At, B1); PG8_BAR;
            }
        }
        if constexpr (ALIGN_EPI) { if (wr == 0) PG8_BAR; }
        if constexpr (!Epi::AFTER_DRAIN) { E(acc, cur, wr, wc, fr, fq); S.done(cur); }
        if (!has_next) break;
#pragma unroll
        for (int a = 0; a < 2; ++a)
#pragma unroll
            for (int b = 0; b < 2; ++b)
#pragma unroll
                for (int m = 0; m < 4; ++m)
#pragma unroll
                    for (int n = 0; n < 2; ++n) acc[a][b][m][n] = (f32x4){0.f, 0.f, 0.f, 0.f};
        cur = nxt; cA = nA; cB = nB; ++ui;
        if constexpr (ALIGN_EPI) { if (wr == 1) PG8_BAR; }
    }
    PG8_WAIT_V(0);
    if constexpr (!ALIGN_EPI) { if (wr == 0) PG8_BAR; }
    PG8_BAR;
    if constexpr (Epi::AFTER_DRAIN) { E.fused(acc, cur, wr, wc, fr, fq, lds, wid, lane); S.done(cur); }
#undef PG8_SA
#undef PG8_SB
#undef PG8_STAGE
#undef PG8_LDA
#undef PG8_LDB
#undef PG8_MMA
#undef PG8_WAIT_V
#undef PG8_WAIT_L
#undef PG8_BAR
#undef PG8_SCHED
}
}
template <class CM>
__device__ __forceinline__ void tr_item(const float* W, int ldw, const float* gain, bf16_t* out, int K, int R0, int k0, const CM& cm, LAS float* scr, int lane) {
    const int col = cm(R0 + (lane & 31));
    {
        float vv[32];
        const float* wp = W + (size_t)(k0 + (lane >> 5)) * ldw + (col >= 0 ? col : 0); const size_t wstep = (size_t)2 * ldw;
#pragma unroll
        for (int i = 0; i < 32; ++i) { vv[i] = *wp; wp += wstep; }
        if (col < 0) {
#pragma unroll
            for (int i = 0; i < 32; ++i) vv[i] = 0.f;
        }
#pragma unroll
        for (int i = 0; i < 32; ++i) { const int kk = 2 * i + (lane >> 5); float v = vv[i]; if (gain) v *= gain[k0 + kk]; scr[kk * 33 + (lane & 31)] = v; }
    }
    asm volatile("s_waitcnt lgkmcnt(0)" ::: "memory");
    const int ch = lane & 7;
#pragma unroll
    for (int j = 0; j < 4; ++j) {
        const int n = (lane >> 3) + 8 * j; const LAS float* s = scr + (8 * ch) * 33 + n;
        u32x4 o; o.x = cvt_pk_bf16(s[0], s[33]); o.y = cvt_pk_bf16(s[66], s[99]); o.z = cvt_pk_bf16(s[132], s[165]); o.w = cvt_pk_bf16(s[198], s[231]);
        *(u32x4*)(out + (size_t)(R0 + n) * K + k0 + 8 * ch) = o;
    }
    asm volatile("s_waitcnt lgkmcnt(0)" ::: "memory");
}
__device__ __forceinline__ int rperm16(int d) { return d < 16 ? ((d & 1) ? (d >> 1) + 8 : (d >> 1)) : d; }
__device__ __forceinline__ int rperm8(int d) { return d < 8 ? ((d & 1) ? (d >> 1) + 4 : (d >> 1)) : d; }
struct CmW1 {
    __device__ __forceinline__ int operator()(int cidx) const {
        const int tt = cidx >> 8, o = cidx & 255;
        switch (tt) {
            case 0: return o;
            case 1: return 256 + o;
            case 2: return 512 + o;
            case 3: return 772 + (o & ~63) + rperm16(o & 63);
            case 4: return 1156 + (o & ~31) + rperm8(o & 31);
            case 5: return 1452 + (o & ~31) + rperm8(o & 31);
            case 6: return 1708 + (o & ~31) + rperm8(o & 31);
            case 7: return 1964 + o;
            case 8: return 2220 + o;
            default:
                if (o < 64) return 1028 + rperm16(o);
                if (o < 128) return 1092 + (o - 64);
                if (o < 160) return 1412 + rperm8(o - 128);
                if (o < 164) return 768 + (o - 160);
                if (o < 172) return 1444 + (o - 164);
                return -1;
        }
    }
};
struct CmId { __device__ __forceinline__ int operator()(int r) const { return r; } };
struct CmG { __device__ __forceinline__ int operator()(int r) const { const int br = 2 * ((r >> 7) & 1) + ((r >> 4) & 1), d = 64 * (r >> 8) + 16 * ((r >> 5) & 3) + (r & 15); return br * DM + d; } };
struct CmF1 { __device__ __forceinline__ int operator()(int r) const { const int j = ((r >> 8) << 7) + (r & 127); return ((r >> 7) & 1) ? FF + j : j; } };

__device__ __forceinline__ void prep_mixer(const Ctx& c0, int l) {
    PHASE_CTX(c0);
    __syncthreads();
    LAS float* scr = (LAS float*)(c.lds + c.wid * 8448);
    const int gw = c.blk * 8 + c.wid, NGW = c.nblk * 8;
    constexpr int I1 = 16 * 80, IG = 16 * 128, IB = 4 * 4 * 32, IO = 16 * 32;
    constexpr int NIT = I1 + IG + IB + IO;
    for (int it = gw; it < NIT; it += NGW) {
        int r = it;
        if (r < I1) { tr_item(c.w_in + (size_t)l * DM * INC, INC, c.norm_mix_g + l * DM, WSP(bf16_t, OFF_W1T), DM, (r % 80) * 32, (r / 80) * 64, CmW1(), scr, c.lane); continue; } r -= I1;
        if (r < IG) { tr_item(c.w_gate + (size_t)l * DM * 4096, 4096, c.norm_mix_g + l * DM, WSP(bf16_t, OFF_WGT), DM, (r % 128) * 32, (r / 128) * 64, CmG(), scr, c.lane); continue; } r -= IG;
        if (r < IB) { const int n = r / 128, q = r % 128; tr_item(c.w_branch + ((size_t)l * 4 + n) * 256 * DM, DM, nullptr, WSP(bf16_t, OFF_WBT) + (size_t)n * DM * 256, 256, (q % 32) * 32, (q / 32) * 64, CmId(), scr, c.lane); continue; } r -= IB;
        tr_item(c.w_out + (size_t)l * DM * DM, DM, nullptr, WSP(bf16_t, OFF_WOT), DM, (r % 32) * 32, (r / 32) * 64, CmId(), scr, c.lane);
    }
    __syncthreads();
}
__device__ __forceinline__ void prep_ffn(const Ctx& c0, int l) {
    PHASE_CTX(c0);
    __syncthreads();
    LAS float* scr = (LAS float*)(c.lds + c.wid * 8448);
    const int gw = c.blk * 8 + c.wid, NGW = c.nblk * 8;
    constexpr int IF1 = 16 * 176, IF2 = 44 * 32;
    for (int it = gw; it < IF1 + IF2; it += NGW) {
        int r = it;
        if (r < IF1) { tr_item(c.w_ffn_in + (size_t)l * DM * 2 * FF, 2 * FF, c.norm_ffn_g + l * DM, WSP(bf16_t, OFF_WF1T), DM, (r % 176) * 32, (r / 176) * 64, CmF1(), scr, c.lane); continue; } r -= IF1;
        tr_item(c.w_ffn_out + (size_t)l * FF * DM, DM, nullptr, WSP(bf16_t, OFF_WF2T), FF, (r % 32) * 32, (r / 32) * 64, CmId(), scr, c.lane);
    }
    __syncthreads();
}

__device__ __forceinline__ void norm_row2(const float* xrow0, const float* xrow1, bf16_t* brow0, bf16_t* brow1, float* rs_out0, float* rs_out1, int lane) {
    const f32x4* xr0 = (const f32x4*)xrow0 + 2 * lane; const f32x4* xr1 = (const f32x4*)xrow1 + 2 * lane;
    f32x4 v[2][4]; float s0 = 0.f, s1 = 0.f;
#pragma unroll
    for (int j = 0; j < 2; ++j) { v[0][2 * j] = xr0[128 * j]; v[0][2 * j + 1] = xr0[128 * j + 1]; v[1][2 * j] = xr1[128 * j]; v[1][2 * j + 1] = xr1[128 * j + 1]; }
#pragma unroll
    for (int j = 0; j < 4; ++j) { s0 += (v[0][j].x * v[0][j].x + v[0][j].y * v[0][j].y) + (v[0][j].z * v[0][j].z + v[0][j].w * v[0][j].w);
                                  s1 += (v[1][j].x * v[1][j].x + v[1][j].y * v[1][j].y) + (v[1][j].z * v[1][j].z + v[1][j].w * v[1][j].w); }
    s0 = wave_sum(s0); s1 = wave_sum(s1);
    if (lane < 16) { rs_out0[lane] = (lane == 0) ? s0 : 0.f; rs_out1[lane] = (lane == 0) ? s1 : 0.f; }
#pragma unroll
    for (int r = 0; r < 2; ++r) { u32x4* o16 = (u32x4*)(r ? brow1 : brow0) + lane;
#pragma unroll
        for (int j = 0; j < 2; ++j) { u32x4 w; w.x = cvt_pk_bf16(v[r][2 * j].x, v[r][2 * j].y); w.y = cvt_pk_bf16(v[r][2 * j].z, v[r][2 * j].w); w.z = cvt_pk_bf16(v[r][2 * j + 1].x, v[r][2 * j + 1].y); w.w = cvt_pk_bf16(v[r][2 * j + 1].z, v[r][2 * j + 1].w); o16[64 * j] = w; } }
}
__device__ __forceinline__ void norm_pass(const Ctx& c0, const float* X) {
    PHASE_CTX(c0);
    const int gw = c.blk * 8 + c.wid, NGW = c.nblk * 8;
    for (int m = 2 * gw; m < T; m += 2 * NGW)
        norm_row2(X + (size_t)m * DM, X + (size_t)(m + 1) * DM, WSP(bf16_t, OFF_XB) + (size_t)m * DM, WSP(bf16_t, OFF_XB) + (size_t)(m + 1) * DM, WSP(float, OFF_SS) + (size_t)m * 16, WSP(float, OFF_SS) + (size_t)(m + 1) * 16, c.lane);
}
__device__ __forceinline__ float rs_of(float ss) { return __builtin_amdgcn_rsqf(ss * (1.0f / DM) + EPS); }
__device__ __forceinline__ float rs_row(const float* ssp, size_t tok) {
    const f32x4* q = (const f32x4*)(ssp + tok * 16); const f32x4 a = q[0], b = q[1], c2 = q[2], d = q[3];
    return rs_of((((a.x + a.y) + (a.z + a.w)) + ((b.x + b.y) + (b.z + b.w))) + (((c2.x + c2.y) + (c2.z + c2.w)) + ((d.x + d.y) + (d.z + d.w))));
}
__device__ __forceinline__ size_t ss_off(int idx) { return (size_t)(idx & 1) * T * 16; }
__device__ __forceinline__ float rs_row_coop(const float* ssp, size_t tok, int fq) {
    const f32x4 a = *(const f32x4*)(ssp + tok * 16 + 4 * fq);
    float s = (a.x + a.y) + (a.z + a.w);
    { const auto r_ = __builtin_amdgcn_permlane16_swap(__float_as_uint(s), __float_as_uint(s), false, false); s = __uint_as_float(r_[0]) + __uint_as_float(r_[1]); }
    { const auto r_ = __builtin_amdgcn_permlane32_swap(__float_as_uint(s), __float_as_uint(s), false, false); s = __uint_as_float(r_[0]) + __uint_as_float(r_[1]); }
    return rs_of(s);
}
__device__ __forceinline__ void final_norm(const Ctx& c0) {
    PHASE_CTX(c0);
    const int gw = c.blk * 8 + c.wid, NGW = c.nblk * 8;
    const float* X = WSP(float, OFF_X);
    for (int m = 2 * gw; m < T; m += 2 * NGW) {
        const f32x4* xr = (const f32x4*)(X + (size_t)m * DM) + c.lane;
        const float rs0 = rs_row(WSP(float, OFF_SS) + ss_off(8), m), rs1 = rs_row(WSP(float, OFF_SS) + ss_off(8), m + 1);
        f32x4* o = (f32x4*)(c.out + (size_t)m * DM) + c.lane; const f32x4* g = (const f32x4*)c.final_norm_g + c.lane;
        f32x4 v[8];
#pragma unroll
        for (int j = 0; j < 8; ++j) v[j] = xr[64 * j];
#pragma unroll
        for (int j = 0; j < 8; ++j) o[64 * j] = v[j] * (j < 4 ? rs0 : rs1) * g[64 * (j & 3)];
    }
}

__device__ __forceinline__ void prologue(const Ctx& c0) {
    PHASE_CTX(c0);
    prep_mixer(c, 0); prep_ffn(c, 0);
    const int gw = c.blk * 8 + c.wid, NGW = c.nblk * 8;
    {
        LAS float* scr = (LAS float*)(c.lds + c.wid * 8448);
        for (int it = gw; it < 4 * 16 * 16; it += NGW) { const int l = it >> 8, r = it & 255;
            tr_item(c.w_mem_kv + (size_t)l * DM * 512, 512, c.norm_mem_g + l * DM, WSP(bf16_t, OFF_WMEMT) + (size_t)l * 512 * DM, DM, (r % 16) * 32, (r / 16) * 64, CmId(), scr, c.lane); }
    }
    for (int m = 2 * gw; m < NB * MEML; m += 2 * NGW) norm_row2(c.mem + (size_t)m * DM, c.mem + (size_t)(m + 1) * DM, WSP(bf16_t, OFF_MEMB) + (size_t)m * DM, WSP(bf16_t, OFF_MEMB) + (size_t)(m + 1) * DM, WSP(float, OFF_MISC) + (size_t)m * 16, WSP(float, OFF_MISC) + (size_t)(m + 1) * 16, c.lane);
    for (int i = c.blk * NTHREADS + c.tid; i < T * 12; i += c.nblk * NTHREADS) {
        const int tok = i / 12, k = i % 12;
        const float p = (float)c.pos[tok];
        if (k < 8) { const float invf = (float)pow(500000.0, -(double)((float)(2 * k) / 16.0f)); const float ang = p * invf; float* o = WSP(float, OFF_CS16) + (size_t)tok * 16 + 2 * k; o[0] = (float)cos((double)ang); o[1] = (float)sin((double)ang); }
        else { const int kk = k - 8; const float invf = (float)pow(500000.0, -(double)((float)(2 * kk) / 8.0f)); const float ang = p * invf; float* o = WSP(float, OFF_CS8) + (size_t)tok * 8 + 2 * kk; o[0] = (float)cos((double)ang); o[1] = (float)sin((double)ang); }
    }
    if (c.blk == 0 && c.tid < DEPTH) {
        const int l = c.tid; const float* lv = c.diff_lambda + l * 128;
        float s1 = 0.f, s2 = 0.f;
        for (int i = 0; i < 32; ++i) { s1 += lv[i] * lv[32 + i]; s2 += lv[64 + i] * lv[96 + i]; }
        const float li = 0.8f - 0.6f * expf(-0.3f * (float)l);
        float* o = WSP(float, OFF_MISC) + 65536 + 2 * l; o[0] = expf(s1) - expf(s2) + li; o[1] = 1.0f - li;
    }
    norm_pass(c, c.x);
}

__device__ __forceinline__ void rope2(f32x4& v, const float* cs) {
    const f32x4 t = *(const f32x4*)cs;
    const float a0 = v.x, b0 = v.y, a1 = v.z, b1 = v.w;
    v.x = a0 * t.x - b0 * t.y; v.y = b0 * t.x + a0 * t.y; v.z = a1 * t.z - b1 * t.w; v.w = b1 * t.z + a1 * t.w;
}
__device__ __forceinline__ void rope2v(f32x4& v, const f32x4 t) {
    const float a0 = v.x, b0 = v.y, a1 = v.z, b1 = v.w;
    v.x = a0 * t.x - b0 * t.y; v.y = b0 * t.x + a0 * t.y; v.z = a1 * t.z - b1 * t.w; v.w = b1 * t.z + a1 * t.w;
}
template <int TT>
__device__ __forceinline__ void z_group(unsigned char* ws, const float* b_forget, int l, size_t tok, int c0, f32x4 v, const f32x4 tab, u32x2* outw = nullptr) {
    const float QS = 0.125f * LOG2E, QS32 = 0.17677669529663687f * LOG2E;
    bool store = true;
    if (TT == 0 || TT == 8) v = v * QS;
    else if (TT == 3) { const int d = c0 & 63; if (d < 16) rope2v(v, tab); v = v * QS; }
    else if (TT == 4 || TT == 6) { const int d = c0 & 31; if (d < 8) rope2v(v, tab); }
    else if (TT == 5) { const int d = c0 & 31; if (d < 8) rope2v(v, tab); v = v * QS32; }
    else if (TT == 9) { const int cc = c0 - 2304;
        const float* cs16 = (const float*)(ws + OFF_CS16) + tok * 16; const float* cs8 = (const float*)(ws + OFF_CS8) + tok * 8;
        if (cc < 64) { if (cc < 16) rope2(v, cs16 + cc); }
        else if (cc < 128) {}
        else if (cc < 160) { const int d = cc - 128; if (d < 8) rope2(v, cs8 + d); }
        else if (cc < 164) { f32x4 o;
#pragma unroll
            for (int i = 0; i < 4; ++i) { const float xx = v[i] + b_forget[l * 4 + i]; o[i] = (fminf(xx, 0.f) - log1pf(expf(-fabsf(xx)))) * LOG2E; }
            *(f32x4*)((float*)(ws + OFF_FL) + tok * 4) = o; store = false; }
        else if (cc < 172) { *(f32x4*)((float*)(ws + OFF_WI) + tok * 8 + (cc - 164)) = v * 0.0625f; store = false; }
        else store = false;
    }
    if (store) { u32x2 w; w.x = cvt_pk_bf16(v.x, v.y); w.y = cvt_pk_bf16(v.z, v.w); if (outw) *outw = w; else *(u32x2*)((bf16_t*)(ws + OFF_Z) + tok * ZP + c0) = w; }
}
struct EpiZ {
    static constexpr bool PERM = false, AFTER_DRAIN = false;
    unsigned char* ws; const float* b_forget; const float* ss; int l;
    template <int TT> __device__ __forceinline__ void run(const f32x4 (&acc)[2][2][4][2], const pg8::Unit& u, int wr, int wc, int fr, int fq) const {
        constexpr bool ROPE = (TT == 3 || TT == 4 || TT == 5 || TT == 6);
        float rs8[2][4]; f32x4 tab[2][4][2];
#pragma unroll
        for (int ai = 0; ai < 2; ++ai)
#pragma unroll
            for (int m = 0; m < 4; ++m) {
                const size_t tok = (size_t)u.pm * 256 + ai * 128 + wr * 64 + m * 16 + fr;
                rs8[ai][m] = rs_row_coop(ss, tok, fq);
#pragma unroll
                for (int bj = 0; bj < 2; ++bj) {
                    tab[ai][m][bj] = (f32x4){1.f, 0.f, 1.f, 0.f};
                    if (ROPE) { const int c0 = u.pn * 256 + bj * 128 + wc * 32 + 4 * fq;
                        const int d = (TT == 3) ? (c0 & 63) : (c0 & 31); const int dd = d < ((TT == 3) ? 16 : 8) ? d : 0;
                        tab[ai][m][bj] = *(const f32x4*)((TT == 3) ? ((const float*)(ws + OFF_CS16) + tok * 16 + dd) : ((const float*)(ws + OFF_CS8) + tok * 8 + dd)); }
                }
            }
#pragma unroll
        for (int ai = 0; ai < 2; ++ai)
#pragma unroll
            for (int m = 0; m < 4; ++m) {
                const size_t tok = (size_t)u.pm * 256 + ai * 128 + wr * 64 + m * 16 + fr;
#pragma unroll
                for (int bj = 0; bj < 2; ++bj) {
                    if (TT == 9) {
#pragma unroll
                        for (int n = 0; n < 2; ++n) z_group<TT>(ws, b_forget, l, tok, u.pn * 256 + bj * 128 + wc * 32 + n * 16 + 4 * fq, acc[ai][bj][m][n] * rs8[ai][m], tab[ai][m][bj]);
                    } else {
                        u32x2 w0, w1;
                        z_group<TT>(ws, b_forget, l, tok, u.pn * 256 + bj * 128 + wc * 32 + 4 * fq, acc[ai][bj][m][0] * rs8[ai][m], tab[ai][m][bj], &w0);
                        z_group<TT>(ws, b_forget, l, tok, u.pn * 256 + bj * 128 + wc * 32 + 16 + 4 * fq, acc[ai][bj][m][1] * rs8[ai][m], tab[ai][m][bj], &w1);
                        asm volatile("s_nop 1" : "+v"(w0.x), "+v"(w0.y), "+v"(w1.x), "+v"(w1.y));
                        const auto s0 = __builtin_amdgcn_permlane16_swap(w0.x, w1.x, false, false);
                        const auto s1 = __builtin_amdgcn_permlane16_swap(w0.y, w1.y, false, false);
                        u32x4 w; w.x = s0[0]; w.y = s1[0]; w.z = s0[1]; w.w = s1[1];
                        st16_wt((bf16_t*)(ws + OFF_Z) + tok * ZP + u.pn * 256 + bj * 128 + wc * 32 + ((fq & 1) ? 16 + 4 * (fq - 1) : 4 * fq), w);
                    }
                }
            }
    }
    __device__ __forceinline__ void operator()(const f32x4 (&acc)[2][2][4][2], const pg8::Unit& u, int wr, int wc, int fr, int fq) const {
        { int ln_; asm volatile("v_mbcnt_lo_u32_b32 %0, -1, 0\n\tv_mbcnt_hi_u32_b32 %0, -1, %0" : "=v"(ln_)); fr = ln_ & 15; fq = ln_ >> 4; }
        switch (u.pn) {
            case 0: case 8: run<0>(acc, u, wr, wc, fr, fq); break;
            case 3: run<3>(acc, u, wr, wc, fr, fq); break;
            case 4: case 6: run<4>(acc, u, wr, wc, fr, fq); break;
            case 5: run<5>(acc, u, wr, wc, fr, fq); break;
            case 9: run<9>(acc, u, wr, wc, fr, fq); break;
            default: run<1>(acc, u, wr, wc, fr, fq); break;
        }
    }
};
__device__ __forceinline__ void p1_units(const Ctx& c0, int l) {
    PHASE_CTX(c0);
    {
        pg8::Gemm g{WSP(bf16_t, OFF_XB), WSP(bf16_t, OFF_W1T), T, ZP, DM}; pg8::StaticOrder S; S.init(T, ZP, c.nblk, c.blk);
        EpiZ E{c.ws, c.b_forget, WSP(float, OFF_SS) + ss_off(2 * l), l};
        pg8::gemm_phase<EpiZ, pg8::StaticOrder, true, true>(c.lds, g, S, E, c.tid);
    }
    if (l == 0) {
        const int fr = c.lane & 15, fq = c.lane >> 4, wr = c.wid >> 2, wc = c.wid & 3;
        __syncthreads();
        for (int u = c.blk; u < 256; u += c.nblk) {
            f32x4 acc[4][2]; acc_zero(acc);
            const int lyr = u >> 6, pm = (u >> 2) & 15, pn = u & 3;
            gemm_tile(acc, WSP(bf16_t, OFF_MEMB) + (size_t)pm * 128 * DM, DM, WSP(bf16_t, OFF_WMEMT) + ((size_t)lyr * 512 + pn * 128) * DM, DM, DM, c.lds, c.tid);
#pragma unroll
            for (int m = 0; m < 4; ++m) {
                const int row = pm * 128 + wr * 64 + m * 16 + fr; const float rs = rs_of(WSP(float, OFF_MISC)[(size_t)row * 16]);
#pragma unroll
                for (int n = 0; n < 2; ++n) { const int c0 = pn * 128 + wc * 32 + n * 16 + 4 * fq; const f32x4 v = acc[m][n] * rs;
                    u32x2 w; w.x = cvt_pk_bf16(v.x, v.y); w.y = cvt_pk_bf16(v.z, v.w); *(u32x2*)(WSP(bf16_t, OFF_MEMKV) + ((size_t)lyr * 2048 + row) * 512 + c0) = w; }
            }
        }
    }
}

__device__ __forceinline__ void scan_unit(const Ctx& c, int bh) {
    const int b = bh >> 2, h = bh & 3;
    const float* fl = WSP(float, OFF_FL) + (size_t)b * SEQ * 4 + h; float* cum = WSP(float, OFF_CUM) + (size_t)bh * SEQ;
    LAS float* wt = (LAS float*)(c.lds);
    float v[8]; float run = 0.f;
#pragma unroll
    for (int i = 0; i < 8; ++i) { run += fl[(size_t)(c.tid * 8 + i) * 4]; v[i] = run; }
    float inc = run;
#pragma unroll
    for (int o = 1; o < 64; o <<= 1) { const float t = __shfl_up(inc, o); if (c.lane >= o) inc += t; }
    if (c.lane == 63) wt[c.wid] = inc;
    __syncthreads();
    float base = inc - run;
    for (int w = 0; w < c.wid; ++w) base += wt[w];
#pragma unroll
    for (int i = 0; i < 8; ++i) cum[c.tid * 8 + i] = base + v[i];
    __syncthreads();
}

__device__ __forceinline__ void indexer_unit(const Ctx& c, int b, int g) {
    int lane = c.lane; asm volatile("" : "+v"(lane));
    const int wid = c.wid, q = lane & 15, kq = lane >> 4;
    const int t = 16 * g + q; const size_t tok = (size_t)b * SEQ + t;
    const bf16_t* Z = WSP(bf16_t, OFF_Z);
    volatile LAS unsigned* cb = (volatile LAS unsigned*)(c.lds);
    bf16x8 qf[8]; float w[8];
#pragma unroll
    for (int hh = 0; hh < 8; ++hh) { qf[hh] = *(const bf16x8*)(Z + tok * ZP + 1024 + hh * 32 + 8 * kq); w[hh] = WSP(float, OFF_WI)[tok * 8 + hh]; }
    const int npairs = (g + 2) >> 1;
    const int nwpairs = 2 * (g >> 2) + 2;
    const int njj = (npairs - wid + 7) >> 3;
    unsigned key[16][8];
    const bf16_t* Zk = Z + (size_t)b * SEQ * ZP + 2432 + 8 * kq;
    const int krmax = 16 * g + 15;
    bf16x8 pf[2][2];
#define KI_LOAD(JJ) do { _Pragma("unroll") for (int tl_ = 0; tl_ < 2; ++tl_) { int kr_ = 32 * (wid + 8 * (JJ)) + 16 * tl_ + q; kr_ = kr_ < krmax ? kr_ : krmax; \
        pf[(JJ) % 2][tl_] = *(const bf16x8*)(Zk + (size_t)kr_ * ZP); } } while (0)
    if (0 < njj) KI_LOAD(0);
#pragma unroll
    for (int jj = 0; jj < 16; ++jj) {
#pragma unroll
        for (int e = 0; e < 8; ++e) key[jj][e] = 0u;
        if (jj < njj) {
            if (jj + 1 < njj) KI_LOAD(jj + 1);
            const int pp = wid + 8 * jj;
#pragma unroll
            for (int tl = 0; tl < 2; ++tl) {
                const int kbase = 32 * pp + 16 * tl;
                if (kbase <= 16 * g) {
                    const bf16x8 af = pf[jj % 2][tl];
                    f32x4 sc = (f32x4){0.f, 0.f, 0.f, 0.f};
                    f32x4 d[8];
#pragma unroll
                    for (int hh = 0; hh < 8; ++hh) d[hh] = __builtin_amdgcn_mfma_f32_16x16x32_bf16(af, qf[hh], (f32x4){0.f, 0.f, 0.f, 0.f}, 0, 0, 0);
#pragma unroll
                    for (int hh = 0; hh < 8; ++hh)
#pragma unroll
                        for (int i = 0; i < 4; ++i) { const int db_ = __float_as_int(d[hh][i]); sc[i] += w[hh] * __int_as_float(db_ > 0 ? db_ : 0); }
#pragma unroll
                    for (int i = 0; i < 4; ++i) { const unsigned bits = __float_as_uint(sc[i]); key[jj][tl * 4 + i] = bits ^ (((unsigned)((int)bits >> 31)) | 0x80000000u); }
                    if (kbase == 16 * g) {
#pragma unroll
                        for (int i = 0; i < 4; ++i) if (kbase + 4 * kq + i > t) key[jj][tl * 4 + i] = 0u;
                    }
                }
            }
            asm volatile("" ::: "memory");
        }
    }
#undef KI_LOAD
    int par = 0;
    unsigned tau = 1u;
    if (g >= 16) {
        volatile LAS unsigned* tf = cb + 512;
        const unsigned nel = 8u * (unsigned)(njj > 0 ? njj : 0);
#define IDX_COUNT_GE(CAND, TOT) do { const unsigned cd_ = (CAND), cm_ = cd_ - 1u; unsigned a0_ = 0u, a1_ = 0u; \
            _Pragma("unroll") for (int jj = 0; jj < 16; ++jj) if (jj < njj) { _Pragma("unroll") for (int e = 0; e < 8; e += 4) { unsigned m0_, m1_, m2_, m3_; \
                asm("v_med3_u32 %0, %1, %2, %3" : "=v"(m0_) : "v"(key[jj][e]), "v"(cm_), "v"(cd_)); asm("v_med3_u32 %0, %1, %2, %3" : "=v"(m1_) : "v"(key[jj][e + 1]), "v"(cm_), "v"(cd_)); \
                asm("v_med3_u32 %0, %1, %2, %3" : "=v"(m2_) : "v"(key[jj][e + 2]), "v"(cm_), "v"(cd_)); asm("v_med3_u32 %0, %1, %2, %3" : "=v"(m3_) : "v"(key[jj][e + 3]), "v"(cm_), "v"(cd_)); \
                a0_ = a0_ + m0_ + m1_; a1_ = a1_ + m2_ + m3_; } } \
            unsigned c_ = (a0_ + a1_) - nel * cm_; \
            { const auto r_ = __builtin_amdgcn_permlane16_swap(c_, c_, false, false); c_ = r_[0] + r_[1]; } \
            { const auto r_ = __builtin_amdgcn_permlane32_swap(c_, c_, false, false); c_ = r_[0] + r_[1]; } \
            if (kq == 0) cb[par * 128 + q * 8 + wid] = c_; \
            __syncthreads(); \
            const u32x4 t0_ = *(const LAS u32x4*)((const LAS unsigned*)cb + par * 128 + q * 8), t1_ = *(const LAS u32x4*)((const LAS unsigned*)cb + par * 128 + q * 8 + 4); \
            par ^= 1; TOT = ((t0_.x + t0_.y) + (t0_.z + t0_.w)) + ((t1_.x + t1_.y) + (t1_.z + t1_.w)); } while (0)
        unsigned kmax, kmin;
        { unsigned m_ = 0u, n_ = 0xFFFFFFFFu;
#pragma unroll
          for (int jj = 0; jj < 16; ++jj) if (jj < njj) {
#pragma unroll
              for (int e = 0; e < 8; ++e) { const unsigned kv_ = key[jj][e], kd_ = kv_ - 1u; m_ = m_ > kv_ ? m_ : kv_; n_ = n_ < kd_ ? n_ : kd_; } }
          { const auto r_ = __builtin_amdgcn_permlane16_swap(m_, m_, false, false); m_ = r_[0] > r_[1] ? r_[0] : r_[1]; }
          { const auto r_ = __builtin_amdgcn_permlane32_swap(m_, m_, false, false); m_ = r_[0] > r_[1] ? r_[0] : r_[1]; }
          { const auto r_ = __builtin_amdgcn_permlane16_swap(n_, n_, false, false); n_ = r_[0] < r_[1] ? r_[0] : r_[1]; }
          { const auto r_ = __builtin_amdgcn_permlane32_swap(n_, n_, false, false); n_ = r_[0] < r_[1] ? r_[0] : r_[1]; }
          if (kq == 0) { cb[par * 128 + q * 8 + wid] = m_; cb[256 + par * 128 + q * 8 + wid] = n_; }
          __syncthreads();
          const u32x4 t0_ = *(const LAS u32x4*)((const LAS unsigned*)cb + par * 128 + q * 8), t1_ = *(const LAS u32x4*)((const LAS unsigned*)cb + par * 128 + q * 8 + 4);
          const u32x4 s0_ = *(const LAS u32x4*)((const LAS unsigned*)cb + 256 + par * 128 + q * 8), s1_ = *(const LAS u32x4*)((const LAS unsigned*)cb + 256 + par * 128 + q * 8 + 4);
          par ^= 1;
          unsigned a_ = t0_.x > t0_.y ? t0_.x : t0_.y, b_ = t0_.z > t0_.w ? t0_.z : t0_.w, c2_ = t1_.x > t1_.y ? t1_.x : t1_.y, d_ = t1_.z > t1_.w ? t1_.z : t1_.w;
          a_ = a_ > b_ ? a_ : b_; c2_ = c2_ > d_ ? c2_ : d_; kmax = a_ > c2_ ? a_ : c2_;
          a_ = s0_.x < s0_.y ? s0_.x : s0_.y; b_ = s0_.z < s0_.w ? s0_.z : s0_.w; c2_ = s1_.x < s1_.y ? s1_.x : s1_.y; d_ = s1_.z < s1_.w ? s1_.z : s1_.w;
          a_ = a_ < b_ ? a_ : b_; c2_ = c2_ < d_ ? c2_ : d_; kmin = (a_ < c2_ ? a_ : c2_) + 1u; }
#define IDX_MAX_XAD(S, D, OUT) do { const unsigned s_ = (S), d_ = (D); unsigned m_ = 0u; \
            _Pragma("unroll") for (int jj = 0; jj < 16; ++jj) if (jj < njj) { _Pragma("unroll") for (int e = 0; e < 8; e += 2) { \
                const unsigned x0_ = (key[jj][e] ^ s_) + d_, x1_ = (key[jj][e + 1] ^ s_) + d_; const unsigned y_ = x0_ > x1_ ? x0_ : x1_; m_ = m_ > y_ ? m_ : y_; } } \
            { const auto r_ = __builtin_amdgcn_permlane16_swap(m_, m_, false, false); m_ = r_[0] > r_[1] ? r_[0] : r_[1]; } \
            { const auto r_ = __builtin_amdgcn_permlane32_swap(m_, m_, false, false); m_ = r_[0] > r_[1] ? r_[0] : r_[1]; } \
            if (kq == 0) cb[par * 128 + q * 8 + wid] = m_; \
            __syncthreads(); \
            const u32x4 t0_ = *(const LAS u32x4*)((const LAS unsigned*)cb + par * 128 + q * 8), t1_ = *(const LAS u32x4*)((const LAS unsigned*)cb + par * 128 + q * 8 + 4); \
            par ^= 1; \
            unsigned a_ = t0_.x > t0_.y ? t0_.x : t0_.y, b_ = t0_.z > t0_.w ? t0_.z : t0_.w, c2_ = t1_.x > t1_.y ? t1_.x : t1_.y, e_ = t1_.z > t1_.w ? t1_.z : t1_.w; \
            a_ = a_ > b_ ? a_ : b_; c2_ = c2_ > e_ ? c2_ : e_; OUT = a_ > c2_ ? a_ : c2_; } while (0)
        const float nf = (float)(t + 1);
#define IDX_NQ(CNT, OUT) do { float c_ = (float)(CNT); c_ = c_ < 0.5f ? 0.5f : c_; c_ = c_ > nf - 0.5f ? nf - 0.5f : c_; \
            OUT = __builtin_amdgcn_logf(nf - c_) - __builtin_amdgcn_logf(c_); } while (0)
        unsigned klo, khi, clo, chi; bool done = false, exact = false;
        { unsigned kp1 = 0x80000001u; asm volatile("" : "+v"(kp1));
          unsigned cpos; IDX_COUNT_GE(kp1, cpos);
          if (cpos > 256u) { klo = kp1; clo = cpos; khi = kmax + 1u; chi = 0u; }
          else if (cpos == 256u) { klo = kp1; clo = cpos; khi = kmax + 1u; chi = 0u; done = true; exact = true; tau = kp1; }
          else { klo = kmin; clo = (unsigned)(t + 1); khi = kp1; chi = cpos; } }
        float tlo, thi, t256; IDX_NQ(clo, tlo); IDX_NQ(chi, thi); IDX_NQ(256u, t256);
        float flo = 1.f, fhi = 1.f; int side = 0; unsigned forced = 0u;
#pragma unroll 1
        for (int it = 0; it < 96; ++it) {
            const unsigned width = khi - klo;
            if (!done && width <= 1u) { done = true; tau = klo; }
            if (__all(done)) break;
            const bool exb = !done && forced == 0u && clo == 257u;
            const bool exa = !done && forced == 0u && !exb && chi == 255u;
            if (__all(done || exa || exb)) {
                unsigned mx; IDX_MAX_XAD(exb ? 0xFFFFFFFFu : 0u, exb ? klo : 0u - khi, mx);
                if (exb) { klo = klo - 1u - mx; forced = klo + 1u; }
                else if (exa) { khi = khi + mx + 1u; forced = khi - 1u; }
                continue;
            }
            unsigned cand = klo + (width >> 1);
            if (it < 24) {
                const float vlo = __uint_as_float((int)klo < 0 ? (klo & 0x7fffffffu) : ~klo), vhi = __uint_as_float((int)khi < 0 ? (khi & 0x7fffffffu) : ~khi);
                const float wa = (t256 - tlo) * flo, wb = (thi - t256) * fhi;
                const unsigned cb_ = __float_as_uint(vlo + (vhi - vlo) * (wa * __builtin_amdgcn_rcpf(wa + wb)));
                cand = cb_ ^ (((unsigned)((int)cb_ >> 31)) | 0x80000000u);
            }
            if (forced != 0u) { cand = forced; forced = 0u; }
            cand = cand <= klo ? klo + 1u : cand; cand = cand >= khi ? khi - 1u : cand;
            if (done) cand = klo;
            unsigned tot; IDX_COUNT_GE(cand, tot);
            if (!done) {
                if (tot == 256u) { done = true; exact = true; tau = cand; }
                else if (tot > 256u) { klo = cand; clo = tot; IDX_NQ(tot, tlo); flo = 1.f; fhi = (side == 1) ? fhi * 0.5f : 1.f; side = 1; }
                else { khi = cand; chi = tot; IDX_NQ(tot, thi); fhi = 1.f; flo = (side == 2) ? flo * 0.5f : 1.f; side = 2; }
            }
        }
#undef IDX_MAX_XAD
#undef IDX_NQ
        if (!done) tau = klo;
        unsigned need = 0u, neq = 0u;
        if (!exact) { need = 256u - chi; neq = clo - chi; }
        if (c.tid == 0) tf[0] = 0u;
        __syncthreads();
        if (neq > need) tf[0] = 1u;
        __syncthreads();
        if (tf[0] != 0u) {
            unsigned lb = 0x80000000u + 4095u - (unsigned)(32 * wid + 4 * kq);
            asm volatile("" : "+v"(lb));
#pragma unroll
            for (int jj = 0; jj < 16; ++jj) if (jj < njj) {
#pragma unroll
                for (int e = 0; e < 8; ++e) { const unsigned kv_ = key[jj][e];
                    key[jj][e] = (kv_ > tau) ? 0xFFFFFFFFu : (kv_ == tau ? (lb - (unsigned)(256 * jj + 16 * (e >> 2) + (e & 3))) : 0u); } }
            unsigned prefix = 0x80000000u;
#pragma unroll 1
            for (int bit = 11; bit >= 0; --bit) {
                const unsigned cand = prefix | (1u << bit);
                unsigned tot; IDX_COUNT_GE(cand, tot);
                if (tot >= 256u) prefix = cand;
            }
            tau = prefix;
        }
#undef IDX_COUNT_GE
        __syncthreads();
    }
    unsigned* maskrow = WSP(unsigned, OFF_MASK) + tok * 128;
#pragma unroll
    for (int jj = 0; jj < 16; ++jj) {
        const int pp = wid + 8 * jj;
        if (pp < nwpairs) {
            unsigned wbits = 0u;
#pragma unroll
            for (int e = 0; e < 8; ++e) wbits |= ((key[jj][e] >= tau) ? 1u : 0u) << (16 * (e >> 2) + 4 * kq + (e & 3));
            { const auto r_ = __builtin_amdgcn_permlane16_swap(wbits, wbits, false, false); wbits = r_[0] | r_[1]; }
            { const auto r_ = __builtin_amdgcn_permlane32_swap(wbits, wbits, false, false); wbits = r_[0] | r_[1]; }
            if (kq == 0) maskrow[pp] = wbits;
        }
    }
}
__device__ __forceinline__ void p2_units(const Ctx& c0, int l, int qo = 0) {
    PHASE_CTX(c0);
    for (int u = c.blk; u < 32; u += c.nblk) scan_unit(c, u);
    const int nstat = (2048 / c.nblk > 2) ? (2048 / c.nblk - 2) : 0;
#pragma unroll 1
    for (int it = 0;; ++it) {
        int v;
        if (it < nstat) v = it * c.nblk + c.blk; else v = nstat * c.nblk + q_next(c, 16 * l + qo);
        if (v >= 2048) break;
        indexer_unit(c, v & 7, 255 - (v >> 3));
    }
}

__device__ __forceinline__ int crow(int r, int hi) { return (r & 3) + 8 * (r >> 2) + 4 * hi; }
constexpr float SM_THR = 6.0f;
struct SoftState { float l; bool seen; f32x16 o[2]; f32x16 negm; };
__device__ __forceinline__ void soft_init(SoftState& s) { s.l = 0.f; s.seen = false; s.o[0] = (f32x16){}; s.o[1] = (f32x16){}; s.negm = (f32x16){}; }
constexpr float SM_GROW = 65536.0f;
__device__ __forceinline__ void soft_grow(SoftState& st) {
    if (__any(st.l > SM_GROW)) {
        const float lp = st.l + __shfl_xor(st.l, 32);
        const int ex = (lp > SM_GROW) ? (int)(__float_as_uint(lp) >> 23) - 127 : 0;
        const float alpha = __uint_as_float((unsigned)(127 - ex) << 23), fe = (float)ex;
        st.l *= alpha;
#pragma unroll
        for (int d = 0; d < 2; ++d)
#pragma unroll
            for (int r = 0; r < 16; ++r) st.o[d][r] *= alpha;
        { const float nm = st.negm[0] - fe;
#pragma unroll
          for (int r = 0; r < 16; ++r) st.negm[r] = nm; }
    }
}
template <bool PK, bool GROW = true>
__device__ __forceinline__ void soft_update(SoftState& st, f32x16 (&S)[2]) {
    if (GROW && __any(st.l > SM_GROW)) {
        const float lp = st.l + __shfl_xor(st.l, 32);
        const int ex = (lp > SM_GROW) ? (int)(__float_as_uint(lp) >> 23) - 127 : 0;
        const float alpha = __uint_as_float((unsigned)(127 - ex) << 23), fe = (float)ex;
#pragma unroll
        for (int p = 0; p < 2; ++p)
#pragma unroll
            for (int r = 0; r < 16; ++r) S[p][r] -= fe;
        st.l *= alpha;
#pragma unroll
        for (int d = 0; d < 2; ++d)
#pragma unroll
            for (int r = 0; r < 16; ++r) st.o[d][r] *= alpha;
        { const float nm = st.negm[0] - fe;
#pragma unroll
          for (int r = 0; r < 16; ++r) st.negm[r] = nm; }
    }
    if (__any(!st.seen)) {
        float mx = S[0][0];
#pragma unroll
        for (int r = 1; r < 16; ++r) mx = fmaxf(mx, S[0][r]);
#pragma unroll
        for (int r = 0; r < 16; ++r) mx = fmaxf(mx, S[1][r]);
        mx = fmaxf(mx, __shfl_xor(mx, 32));
        const bool valid = mx != -INFINITY, first = valid && !st.seen;
        if (__any(first)) {
            const float delta = first ? mx : 0.f;
#pragma unroll
            for (int p = 0; p < 2; ++p)
#pragma unroll
                for (int r = 0; r < 16; ++r) S[p][r] -= delta;
            { const float nm = st.negm[0] - delta;
#pragma unroll
              for (int r = 0; r < 16; ++r) st.negm[r] = nm; }
        }
        st.seen = st.seen || valid;
    }
    f32x2 rs2 = (f32x2){0.f, 0.f};
#pragma unroll
    for (int p = 0; p < 2; ++p)
#pragma unroll
        for (int r = 0; r < 16; r += 2) { const float e0 = fexp2(S[p][r]), e1 = fexp2(S[p][r + 1]); S[p][r] = e0; S[p][r + 1] = e1; rs2 += (f32x2){e0, e1}; }
    st.l += rs2.x + rs2.y;
}
__device__ __forceinline__ bf16x8 pack_p(const f32x16& S, int s) {
    u32x4 w; w.x = cvt_pk_bf16_c(S[8 * s + 0], S[8 * s + 1]); w.y = cvt_pk_bf16_c(S[8 * s + 2], S[8 * s + 3]); w.z = cvt_pk_bf16_c(S[8 * s + 4], S[8 * s + 5]); w.w = cvt_pk_bf16_c(S[8 * s + 6], S[8 * s + 7]);
    return __builtin_bit_cast(bf16x8, w);
}
__device__ __forceinline__ bf16x8 vfrag(const LAS unsigned char* vp) {
    const v4i16_t lo = __builtin_amdgcn_ds_read_tr16_b64_v4i16((LAS v4i16_t*)vp);
    const v4i16_t hi = __builtin_amdgcn_ds_read_tr16_b64_v4i16((LAS v4i16_t*)(vp + 512));
    return (bf16x8){lo[0], lo[1], lo[2], lo[3], hi[0], hi[1], hi[2], hi[3]};
}
__device__ __forceinline__ void glds16(const void* gsrc, unsigned lds_dst) { unsigned keep;
    asm volatile("s_mov_b32 %0, m0\n\ts_mov_b32 m0, %2\n\ts_nop 0\n\tglobal_load_lds_dwordx4 %1, off\n\ts_mov_b32 m0, %0" : "=&s"(keep) : "v"(gsrc), "s"(lds_dst) : "memory"); }
__device__ __forceinline__ void glds4(const void* gsrc, unsigned lds_dst) { unsigned keep;
    asm volatile("s_mov_b32 %0, m0\n\ts_mov_b32 m0, %2\n\ts_nop 0\n\tglobal_load_lds_dword %1, off\n\ts_mov_b32 m0, %0" : "=&s"(keep) : "v"(gsrc), "s"(lds_dst) : "memory"); }
constexpr int ATT_SLOT = 17408;
constexpr int ATT_NSLOT = 4;
#define ATT_WAIT_BAR(n) do { switch (n) { case 0: asm volatile("s_waitcnt vmcnt(0) lgkmcnt(0)\n\ts_barrier" ::: "memory"); break; case 2: asm volatile("s_waitcnt vmcnt(2) lgkmcnt(0)\n\ts_barrier" ::: "memory"); break; \
    case 3: asm volatile("s_waitcnt vmcnt(3) lgkmcnt(0)\n\ts_barrier" ::: "memory"); break; case 4: asm volatile("s_waitcnt vmcnt(4) lgkmcnt(0)\n\ts_barrier" ::: "memory"); break; \
    default: asm volatile("s_waitcnt vmcnt(6) lgkmcnt(0)\n\ts_barrier" ::: "memory"); break; } } while (0)

template <int MODE, int SLOT, int NQS>
__device__ __forceinline__ void att_tile(const LAS unsigned char* lds, int j, int mp, const bf16x8 (&qf)[NQS], SoftState& sa, int t0, int tq, int r32, int hi, int vb, int mq, float cq) {
    const LAS unsigned char* kb = lds + SLOT * ATT_SLOT; const LAS unsigned char* vbase = kb + 8192 + vb; const LAS unsigned char* xb = kb + 16384;
    soft_grow(sa);
    f32x16 S[2]; S[0] = (f32x16){}; S[1] = (f32x16){};
    if (MODE == 0) {
        const float cmq = cq + sa.negm[0];
#pragma unroll
        for (int p = 0; p < 2; ++p)
#pragma unroll
            for (int gq = 0; gq < 4; ++gq) { const f32x4 ck = *(const LAS f32x4*)(xb + (32 * p + 8 * gq + 4 * hi) * 4);
#pragma unroll
                for (int i = 0; i < 4; ++i) S[p][4 * gq + i] = cmq - ck[i]; }
    }
    {
        bf16x8 kf[NQS][2];
#pragma unroll
        for (int s = 0; s < NQS; ++s)
#pragma unroll
            for (int p = 0; p < 2; ++p) kf[s][p] = *(const LAS bf16x8*)(kb + sw_off(32 * p + r32, 2 * (NQS * mp + s) + hi));
#pragma unroll
        for (int s = 0; s < NQS; ++s)
#pragma unroll
            for (int p = 0; p < 2; ++p) S[p] = __builtin_amdgcn_mfma_f32_32x32x16_bf16(kf[s][p], qf[s], (s == 0 && MODE != 0) ? sa.negm : S[p], 0, 0, 0);
    }
    constexpr bool VPRE = (MODE != 3);
    bf16x8 vf[2][2][2];
    if (VPRE) {
#pragma unroll
        for (int p = 0; p < 2; ++p)
#pragma unroll
            for (int s = 0; s < 2; ++s)
#pragma unroll
                for (int db = 0; db < 2; ++db) vf[p][s][db] = vfrag(vbase + db * 4096 + p * 2048 + s * 1024);
    }
    if (MODE == 0 || MODE == 2) {
        if (64 * j + 63 > t0) {
#pragma unroll
            for (int p = 0; p < 2; ++p)
#pragma unroll
                for (int r = 0; r < 16; ++r) { const int kv = 64 * j + 32 * p + crow(r, hi); if (kv > tq) S[p][r] = -INFINITY; }
        }
    }
    if (MODE == 1) {
#pragma unroll
        for (int p = 0; p < 2; ++p) { const unsigned wsh = *(const LAS unsigned*)(xb + mq * 16 + ((j & 1) * 2 + p) * 4) >> (4 * hi);
#pragma unroll
            for (int r = 0; r < 16; ++r) { const unsigned t_ = (unsigned)__builtin_amdgcn_sbfe((int)wsh, (r & 3) + 8 * (r >> 2), 1);
                            S[p][r] = __uint_as_float((__float_as_uint(S[p][r]) & t_) | (0xFF800000u & ~t_)); } }
    }
    soft_update<true, false>(sa, S);
#pragma unroll
    for (int p = 0; p < 2; ++p)
#pragma unroll
        for (int s = 0; s < 2; ++s) {
            const bf16x8 pa = pack_p(S[p], s);
#pragma unroll
            for (int db = 0; db < 2; ++db) { const bf16x8 vv = VPRE ? vf[p][s][db] : vfrag(vbase + db * 4096 + p * 2048 + s * 1024);
                sa.o[db] = __builtin_amdgcn_mfma_f32_32x32x16_bf16(vv, pa, sa.o[db], 0, 0, 0); }
        }
}

template <int SLOT>
__device__ __forceinline__ void att_tile2(const LAS unsigned char* lds, int j, const bf16x8 (&qf)[4], SoftState& sa, f32x16 (&oB)[2], float& lB, int t0, int tq, int r32, int hi, int vb) {
    const LAS unsigned char* kb = lds + SLOT * ATT_SLOT; const LAS unsigned char* vbase = kb + 8192 + vb;
    if (__any(sa.l > SM_GROW || lB > SM_GROW)) {
        const float lpa = sa.l + __shfl_xor(sa.l, 32), lpb = lB + __shfl_xor(lB, 32); const float lp = lpa > lpb ? lpa : lpb;
        const int ex = (lp > SM_GROW) ? (int)(__float_as_uint(lp) >> 23) - 127 : 0;
        const float alpha = __uint_as_float((unsigned)(127 - ex) << 23), fe = (float)ex;
        sa.l *= alpha; lB *= alpha;
#pragma unroll
        for (int d = 0; d < 2; ++d)
#pragma unroll
            for (int r = 0; r < 16; ++r) { sa.o[d][r] *= alpha; oB[d][r] *= alpha; }
        { const float nm = sa.negm[0] - fe;
#pragma unroll
          for (int r = 0; r < 16; ++r) sa.negm[r] = nm; }
    }
    const bool diag = 64 * j + 63 > t0;
    f32x16 SA[2], SB[2];
    {   bf16x8 kf[4][2];
#pragma unroll
        for (int s = 0; s < 4; ++s)
#pragma unroll
            for (int p = 0; p < 2; ++p) kf[s][p] = *(const LAS bf16x8*)(kb + sw_off(32 * p + r32, 2 * s + hi));
#pragma unroll
        for (int p = 0; p < 2; ++p) { SA[p] = __builtin_amdgcn_mfma_f32_32x32x16_bf16(kf[0][p], qf[0], sa.negm, 0, 0, 0); SA[p] = __builtin_amdgcn_mfma_f32_32x32x16_bf16(kf[1][p], qf[1], SA[p], 0, 0, 0);
                                      SB[p] = __builtin_amdgcn_mfma_f32_32x32x16_bf16(kf[2][p], qf[2], sa.negm, 0, 0, 0); SB[p] = __builtin_amdgcn_mfma_f32_32x32x16_bf16(kf[3][p], qf[3], SB[p], 0, 0, 0); }
    }
    if (diag) {
#pragma unroll
        for (int p = 0; p < 2; ++p)
#pragma unroll
            for (int r = 0; r < 16; ++r) { const int kv = 64 * j + 32 * p + crow(r, hi); if (kv > tq) { SA[p][r] = -INFINITY; SB[p][r] = -INFINITY; } }
    }
    if (__any(!sa.seen)) {
        float mx = SA[0][0];
#pragma unroll
        for (int r = 1; r < 16; ++r) mx = fmaxf(mx, SA[0][r]);
#pragma unroll
        for (int r = 0; r < 16; ++r) mx = fmaxf(mx, SA[1][r]);
        mx = fmaxf(mx, __shfl_xor(mx, 32));
        const bool valid = mx != -INFINITY, first = valid && !sa.seen;
        if (__any(first)) {
            const float delta = first ? mx : 0.f;
#pragma unroll
            for (int p = 0; p < 2; ++p)
#pragma unroll
                for (int r = 0; r < 16; ++r) { SA[p][r] -= delta; SB[p][r] -= delta; }
            { const float nm = sa.negm[0] - delta;
#pragma unroll
              for (int r = 0; r < 16; ++r) sa.negm[r] = nm; }
        }
        sa.seen = sa.seen || valid;
    }
    bf16x8 vf[2][2][2];
#pragma unroll
    for (int p = 0; p < 2; ++p)
#pragma unroll
        for (int s = 0; s < 2; ++s)
#pragma unroll
            for (int db = 0; db < 2; ++db) vf[p][s][db] = vfrag(vbase + db * 4096 + p * 2048 + s * 1024);
    f32x2 ra = (f32x2){0.f, 0.f}, rb = (f32x2){0.f, 0.f};
#pragma unroll
    for (int p = 0; p < 2; ++p)
#pragma unroll
        for (int r = 0; r < 16; r += 2) { const float e0 = fexp2(SA[p][r]), e1 = fexp2(SA[p][r + 1]); SA[p][r] = e0; SA[p][r + 1] = e1; ra += (f32x2){e0, e1}; }
#pragma unroll
    for (int p = 0; p < 2; ++p)
#pragma unroll
        for (int s = 0; s < 2; ++s) { const bf16x8 pa = pack_p(SA[p], s);
#pragma unroll
            for (int db = 0; db < 2; ++db) sa.o[db] = __builtin_amdgcn_mfma_f32_32x32x16_bf16(vf[p][s][db], pa, sa.o[db], 0, 0, 0); }
#pragma unroll
    for (int p = 0; p < 2; ++p)
#pragma unroll
        for (int r = 0; r < 16; r += 2) { const float e0 = fexp2(SB[p][r]), e1 = fexp2(SB[p][r + 1]); SB[p][r] = e0; SB[p][r + 1] = e1; rb += (f32x2){e0, e1}; }
#pragma unroll
    for (int p = 0; p < 2; ++p)
#pragma unroll
        for (int s = 0; s < 2; ++s) { const bf16x8 pa = pack_p(SB[p], s);
#pragma unroll
            for (int db = 0; db < 2; ++db) oB[db] = __builtin_amdgcn_mfma_f32_32x32x16_bf16(vf[p][s][db], pa, oB[db], 0, 0, 0); }
    sa.l += ra.x + ra.y; lB += rb.x + rb.y;
}

template <int MODE>
__device__ __forceinline__ void attn_unit(const Ctx& c, int l, int b, int hd, int qblk) {
    int lane = c.lane; asm volatile("" : "+v"(lane));
    const int wid = c.wid, r32 = lane & 31, hi = lane >> 5;
    const bf16_t* Z = WSP(bf16_t, OFF_Z);
    const size_t rowb = (size_t)b * SEQ;
    int head, t0, NT, kpitch; const bf16_t *Qp, *Kp, *Vp; int ocol;
    if (MODE == 0) { head = hd; t0 = qblk * 256 + wid * 32; NT = 4 * (qblk + 1); Qp = Z + 0 + head * 64; Kp = Z + rowb * ZP + 256 + head * 64; Vp = Z + rowb * ZP + 512 + head * 64; kpitch = ZP; ocol = 0 + head * 64; }
    else if (MODE == 1) { head = wid & 3; t0 = qblk * 64 + (wid >> 2) * 32; NT = qblk + 1; Qp = Z + 768 + head * 64; Kp = Z + rowb * ZP + 2304; Vp = Z + rowb * ZP + 2368; kpitch = ZP; ocol = 256 + head * 64; }
    else if (MODE == 2) { head = hd; t0 = qblk * 256 + wid * 32; NT = 4 * (qblk + 1); Qp = Z + 1280 + head * 64; Kp = Z + rowb * ZP + 1536 + head * 64; Vp = Z + rowb * ZP + 1792 + head * 64; kpitch = ZP; ocol = 512 + head * 64; }
    else { head = hd; t0 = qblk * 256 + wid * 32; NT = 4; Qp = Z + 2048 + head * 64; const bf16_t* kv = WSP(bf16_t, OFF_MEMKV) + ((size_t)l * 2048 + (size_t)b * MEML) * 512; Kp = kv + head * 64; Vp = kv + 256 + head * 64; kpitch = 512; ocol = 768 + head * 64; }
    const int tq = t0 + r32;
    const size_t qtok = rowb + tq;
    float cq = 0.f;
    if (MODE == 0) cq = WSP(float, OFF_CUM)[((size_t)b * 4 + head) * SEQ + tq];
    const int krow = 8 * wid + (lane >> 3), kch = (lane & 7) ^ ((krow >> 1) & 7);
    const bf16_t* kg = Kp + (size_t)krow * kpitch + kch * 8;
    const bf16_t* vg = Vp + (size_t)(16 * (wid & 3) + (lane >> 2)) * kpitch + (wid >> 2) * 32 + (lane & 3) * 8;
    const float* cg = WSP(float, OFF_CUM) + ((size_t)b * 4 + head) * SEQ + 4 * lane;
    const unsigned* mg = WSP(unsigned, OFF_MASK) + (rowb + (size_t)qblk * 64 + lane) * 128;
    const int nops = ((MODE == 0 && wid == 0) || (MODE == 1 && wid == 1)) ? 3 : 2;
    const size_t tstep = (size_t)64 * kpitch;
    const unsigned lds0 = (unsigned)(uintptr_t)c.lds;
    const bf16_t* kgn = kg; const bf16_t* vgn = vg; const float* cgn = cg;
#define ATT_ISSUE(J, SL) do { \
        glds16(kgn, (unsigned)__builtin_amdgcn_readfirstlane(lds0 + (SL) * ATT_SLOT + wid * 1024)); kgn += tstep; \
        glds16(vgn, (unsigned)__builtin_amdgcn_readfirstlane(lds0 + (SL) * ATT_SLOT + 8192 + wid * 1024)); vgn += tstep; \
        if (MODE == 0 && wid == 0) { glds16(cgn, (unsigned)__builtin_amdgcn_readfirstlane(lds0 + (SL) * ATT_SLOT + 16384)); cgn += 64; } \
        if (MODE == 1 && wid == 1) glds16(mg + 4 * ((J) >> 1), (unsigned)__builtin_amdgcn_readfirstlane(lds0 + (SL) * ATT_SLOT + 16384)); } while (0)
#define ATT_STEP(J, SL) do { const int j_ = (J); const int ah_ = (NT - 1 - j_) < 2 ? (NT - 1 - j_) : 2; ATT_WAIT_BAR(nops * ah_); \
        if (j_ + 3 < NT) ATT_ISSUE(j_ + 3, ((SL) + 3) & 3); \
        if ((MODE == 3) || (64 * j_ <= t0 + 31)) { if constexpr (MODE == 2) att_tile2<SL>(c.lds, j_, qf, sa, o1, lB, t0, tq, r32, hi, vb); else att_tile<MODE, SL, NQS>(c.lds, j_, mp, qf, sa, t0, tq, r32, hi, vb, mq, cq); } } while (0)
    const int vb = (4 * hi + ((lane & 15) >> 2)) * 64 + ((lane >> 4) & 1) * 32 + (lane & 3) * 8;
    const int mq = (MODE == 1) ? ((wid >> 2) * 32 + r32) : 0;
    constexpr int NMAP = 1;
    constexpr int NQS = 4;
    f32x16 o1[2]; o1[0] = (f32x16){}; o1[1] = (f32x16){}; float lB = 0.f;
    SoftState sa;
#pragma unroll 1
    for (int mp = 0; mp < NMAP; ++mp) {
        bf16x8 qf[NQS];
#pragma unroll
        for (int s = 0; s < NQS; ++s) qf[s] = *(const bf16x8*)(Qp + qtok * ZP + 16 * (NQS * mp + s) + 8 * hi);
#pragma unroll
        for (int s = 0; s < NQS; ++s) asm volatile("" : "+v"(qf[s]));
        asm volatile("" : "+v"(cq));
        soft_init(sa);
        ATT_ISSUE(0, 0); if (NT > 1) ATT_ISSUE(1, 1); if (NT > 2) ATT_ISSUE(2, 2);
#pragma unroll 1
        for (int j0 = 0; j0 < NT; j0 += 4) {
            ATT_STEP(j0, 0);
            if (j0 + 1 < NT) ATT_STEP(j0 + 1, 1);
            if (j0 + 2 < NT) ATT_STEP(j0 + 2, 2);
            if (j0 + 3 < NT) ATT_STEP(j0 + 3, 3);
        }
        asm volatile("s_waitcnt lgkmcnt(0)\n\ts_barrier" ::: "memory");
    }
#undef ATT_ISSUE
#undef ATT_STEP
    const float la = sa.l + __shfl_xor(sa.l, 32); const float ia = __builtin_amdgcn_rcpf(la);
    bf16_t* orow; int hi_e;
    {
        int ln_; asm volatile("v_mbcnt_lo_u32_b32 %0, -1, 0\n\tv_mbcnt_hi_u32_b32 %0, -1, %0" : "=v"(ln_));
        hi_e = ln_ >> 5;
        orow = WSP(bf16_t, OFF_O) + (size_t)(ocol >> 8) * T * 256 + (rowb + (size_t)(t0 + (ln_ & 31))) * 256 + (ocol & 255);
    }
    if (MODE != 2) {
#pragma unroll
        for (int db = 0; db < 2; ++db)
#pragma unroll
            for (int g2 = 0; g2 < 4; g2 += 2) {
                unsigned a0 = cvt_pk_bf16_c(sa.o[db][4 * g2] * ia, sa.o[db][4 * g2 + 1] * ia), a1 = cvt_pk_bf16_c(sa.o[db][4 * g2 + 2] * ia, sa.o[db][4 * g2 + 3] * ia);
                unsigned b0 = cvt_pk_bf16_c(sa.o[db][4 * g2 + 4] * ia, sa.o[db][4 * g2 + 5] * ia), b1 = cvt_pk_bf16_c(sa.o[db][4 * g2 + 6] * ia, sa.o[db][4 * g2 + 7] * ia);
                const auto s0 = __builtin_amdgcn_permlane32_swap(a0, b0, false, false); const auto s1 = __builtin_amdgcn_permlane32_swap(a1, b1, false, false);
                u32x4 w; w.x = s0[0]; w.y = s1[0]; w.z = s0[1]; w.w = s1[1];
                *(u32x4*)(orow + 32 * db + 8 * (g2 + hi_e)) = w; }
    } else {
        const float lam = WSP(float, OFF_MISC)[65536 + 2 * l], oml = WSP(float, OFF_MISC)[65536 + 2 * l + 1];
        const float lb2 = lB + __shfl_xor(lB, 32); const float iab = __builtin_amdgcn_rcpf(lb2);
        float ss = 0.f;
#pragma unroll
        for (int db = 0; db < 2; ++db)
#pragma unroll
            for (int r = 0; r < 16; ++r) { const float v = sa.o[db][r] * ia - lam * (o1[db][r] * iab); o1[db][r] = v; ss += v * v; }
        ss += __shfl_xor(ss, 32);
        const float rstd = __builtin_amdgcn_rsqf(ss * (1.0f / 64.0f) + EPS) * oml;
        const float* sg = c.diff_subln_g + l * 64;
#pragma unroll
        for (int db = 0; db < 2; ++db)
#pragma unroll
            for (int g2 = 0; g2 < 4; g2 += 2) { unsigned pk[2][2];
#pragma unroll
                for (int k = 0; k < 2; ++k) { const int gq = g2 + k, d = 32 * db + 8 * gq + 4 * hi_e; const f32x4 gg = *(const f32x4*)(sg + d);
                    pk[k][0] = cvt_pk_bf16_c(o1[db][4 * gq] * rstd * gg.x, o1[db][4 * gq + 1] * rstd * gg.y); pk[k][1] = cvt_pk_bf16_c(o1[db][4 * gq + 2] * rstd * gg.z, o1[db][4 * gq + 3] * rstd * gg.w); }
                const auto s0 = __builtin_amdgcn_permlane32_swap(pk[0][0], pk[1][0], false, false); const auto s1 = __builtin_amdgcn_permlane32_swap(pk[0][1], pk[1][1], false, false);
                u32x4 w; w.x = s0[0]; w.y = s1[0]; w.z = s0[1]; w.w = s1[1];
                *(u32x4*)(orow + 32 * db + 8 * (g2 + hi_e)) = w; }
    }
}
constexpr int ATT_BUF = 16640;

template <int MODE>
__device__ __forceinline__ void attn_unit_rs(const Ctx& c, int l, int b, int hd, int qblk) {
    const int lane = c.lane, wid = c.wid, r32 = lane & 31, hi = lane >> 5, tid = c.tid;
    const bf16_t* Z = WSP(bf16_t, OFF_Z);
    const size_t rowb = (size_t)b * SEQ;
    int head, t0, NT, kpitch; const bf16_t *Qp, *Kp, *Vp; int ocol;
    if (MODE == 0) { head = hd; t0 = qblk * 256 + wid * 32; NT = 4 * (qblk + 1); Qp = Z + 0 + head * 64; Kp = Z + rowb * ZP + 256 + head * 64; Vp = Z + rowb * ZP + 512 + head * 64; kpitch = ZP; ocol = 0 + head * 64; }
    else if (MODE == 1) { head = wid & 3; t0 = qblk * 64 + (wid >> 2) * 32; NT = qblk + 1; Qp = Z + 768 + head * 64; Kp = Z + rowb * ZP + 2304; Vp = Z + rowb * ZP + 2368; kpitch = ZP; ocol = 256 + head * 64; }
    else if (MODE == 2) { head = hd; t0 = qblk * 256 + wid * 32; NT = 4 * (qblk + 1); Qp = Z + 1280 + head * 64; Kp = Z + rowb * ZP + 1536 + head * 64; Vp = Z + rowb * ZP + 1792 + head * 64; kpitch = ZP; ocol = 512 + head * 64; }
    else { head = hd; t0 = qblk * 256 + wid * 32; NT = 4; Qp = Z + 2048 + head * 64; const bf16_t* kv = WSP(bf16_t, OFF_MEMKV) + ((size_t)l * 2048 + (size_t)b * MEML) * 512; Kp = kv + head * 64; Vp = kv + 256 + head * 64; kpitch = 512; ocol = 768 + head * 64; }
    const int tq = t0 + r32;
    const size_t qtok = rowb + tq;
    float cq = 0.f;
    if (MODE == 0) cq = WSP(float, OFF_CUM)[((size_t)b * 4 + head) * SEQ + tq];
    const unsigned* mrow = WSP(unsigned, OFF_MASK) + qtok * 128;
    const int srow = tid >> 3, sch = tid & 7;
    const int koff = sw_off(srow, sch), voff = 8192 + (sch >> 2) * 4096 + srow * 64 + (sch & 3) * 16;
    const bf16_t* kg = Kp + (size_t)srow * kpitch + sch * 8; const bf16_t* vg = Vp + (size_t)srow * kpitch + sch * 8;
    const float* cg = WSP(float, OFF_CUM) + ((size_t)b * 4 + head) * SEQ + (tid & 63);
    const int vb = (4 * hi + ((lane & 15) >> 2)) * 64 + ((lane >> 4) & 1) * 32 + (lane & 3) * 8;
    constexpr int NMAP = (MODE == 2) ? 2 : 1;
    constexpr int NQS = (MODE == 2) ? 2 : 4;
    f32x16 o1[2]; o1[0] = (f32x16){}; o1[1] = (f32x16){};
    SoftState sa;
#pragma unroll 1
    for (int mp = 0; mp < NMAP; ++mp) {
        bf16x8 qf[NQS];
#pragma unroll
        for (int s = 0; s < NQS; ++s) qf[s] = *(const bf16x8*)(Qp + qtok * ZP + 16 * (NQS * mp + s) + 8 * hi);
        soft_init(sa);
        u32x4 rk = *(const u32x4*)kg, rv = *(const u32x4*)vg; float rc = 0.f;
        if (MODE == 0 && tid < 64) rc = cg[0];
        *(LAS u32x4*)(c.lds + koff) = rk; *(LAS u32x4*)(c.lds + voff) = rv; if (MODE == 0 && tid < 64) *(LAS float*)(c.lds + 16384 + tid * 4) = rc;
        __syncthreads();
#pragma unroll 1
        for (int j = 0; j < NT; ++j) {
            const int cur = (j & 1) * ATT_BUF, nxt = ATT_BUF - cur;
            const bool more = j + 1 < NT;
            if (more) { const size_t ro = (size_t)(j + 1) * 64 * kpitch; rk = *(const u32x4*)(kg + ro); rv = *(const u32x4*)(vg + ro); if (MODE == 0 && tid < 64) rc = cg[(size_t)(j + 1) * 64]; }
            const bool active = (MODE == 3) || (64 * j <= t0 + 31);
            if (active) {
                const LAS unsigned char* kb = c.lds + cur; const LAS unsigned char* vbase = c.lds + cur + 8192 + vb;
                u32x2 mw = (u32x2){0u, 0u};
                if (MODE == 1) mw = *(const u32x2*)(mrow + 2 * j);
                f32x16 S[2]; S[0] = (f32x16){}; S[1] = (f32x16){};
                if (MODE == 0) {
#pragma unroll
                    for (int p = 0; p < 2; ++p)
#pragma unroll
                        for (int gq = 0; gq < 4; ++gq) { const f32x4 ck = *(const LAS f32x4*)(c.lds + cur + 16384 + (32 * p + 8 * gq + 4 * hi) * 4);
#pragma unroll
                            for (int i = 0; i < 4; ++i) S[p][4 * gq + i] = (cq + sa.negm[0]) - ck[i]; }
                }
                {
                    bf16x8 kf[NQS][2];
#pragma unroll
                    for (int s = 0; s < NQS; ++s)
#pragma unroll
                        for (int p = 0; p < 2; ++p) kf[s][p] = *(const LAS bf16x8*)(kb + sw_off(32 * p + r32, 2 * (NQS * mp + s) + hi));
#pragma unroll
                    for (int s = 0; s < NQS; ++s)
#pragma unroll
                        for (int p = 0; p < 2; ++p) S[p] = __builtin_amdgcn_mfma_f32_32x32x16_bf16(kf[s][p], qf[s], (s == 0 && MODE != 0) ? sa.negm : S[p], 0, 0, 0);
                }
                constexpr bool VPRE = true;
                bf16x8 vf[2][2][2];
                if (VPRE) {
#pragma unroll
                    for (int p = 0; p < 2; ++p)
#pragma unroll
                        for (int s = 0; s < 2; ++s)
#pragma unroll
                            for (int db = 0; db < 2; ++db) vf[p][s][db] = vfrag(vbase + db * 4096 + p * 2048 + s * 1024);
                }
                if (MODE == 0 || MODE == 2) {
                    if (64 * j + 63 > t0) {
#pragma unroll
                        for (int p = 0; p < 2; ++p)
#pragma unroll
                            for (int r = 0; r < 16; ++r) { const int kv = 64 * j + 32 * p + crow(r, hi); if (kv > tq) S[p][r] = -INFINITY; }
                    }
                }
                if (MODE == 1) {
#pragma unroll
                    for (int p = 0; p < 2; ++p) { const unsigned wsh = (p == 0 ? mw.x : mw.y) >> (4 * hi);
#pragma unroll
                        for (int r = 0; r < 16; ++r) { const unsigned t_ = (unsigned)__builtin_amdgcn_sbfe((int)wsh, (r & 3) + 8 * (r >> 2), 1);
                            S[p][r] = __uint_as_float((__float_as_uint(S[p][r]) & t_) | (0xFF800000u & ~t_)); } }
                }
                soft_update<true>(sa, S);
#pragma unroll
                for (int p = 0; p < 2; ++p)
#pragma unroll
                    for (int s = 0; s < 2; ++s) {
                        const bf16x8 pa = pack_p(S[p], s);
#pragma unroll
                        for (int db = 0; db < 2; ++db) { const bf16x8 vv = VPRE ? vf[p][s][db] : vfrag(vbase + db * 4096 + p * 2048 + s * 1024);
                            sa.o[db] = __builtin_amdgcn_mfma_f32_32x32x16_bf16(vv, pa, sa.o[db], 0, 0, 0); }
                    }
            }
            if (more) { *(LAS u32x4*)(c.lds + nxt + koff) = rk; *(LAS u32x4*)(c.lds + nxt + voff) = rv; if (MODE == 0 && tid < 64) *(LAS float*)(c.lds + nxt + 16384 + tid * 4) = rc; }
            __syncthreads();
        }
        if (MODE == 2 && mp == 0) {
            const float la = sa.l + __shfl_xor(sa.l, 32); const float ia = __builtin_amdgcn_rcpf(la);
#pragma unroll
            for (int db = 0; db < 2; ++db)
#pragma unroll
                for (int r = 0; r < 16; ++r) o1[db][r] = sa.o[db][r] * ia;
        }
    }
    const float la = sa.l + __shfl_xor(sa.l, 32); const float ia = __builtin_amdgcn_rcpf(la);
    bf16_t* orow = WSP(bf16_t, OFF_O) + (size_t)(ocol >> 8) * T * 256 + qtok * 256 + (ocol & 255);
    if (MODE != 2) {
#pragma unroll
        for (int db = 0; db < 2; ++db)
#pragma unroll
            for (int gq = 0; gq < 4; ++gq) { u32x2 w; w.x = cvt_pk_bf16(sa.o[db][4 * gq] * ia, sa.o[db][4 * gq + 1] * ia); w.y = cvt_pk_bf16(sa.o[db][4 * gq + 2] * ia, sa.o[db][4 * gq + 3] * ia);
                *(u32x2*)(orow + 32 * db + 8 * gq + 4 * hi) = w; }
    } else {
        const float lam = WSP(float, OFF_MISC)[65536 + 2 * l], oml = WSP(float, OFF_MISC)[65536 + 2 * l + 1];
        float ss = 0.f;
#pragma unroll
        for (int db = 0; db < 2; ++db)
#pragma unroll
            for (int r = 0; r < 16; ++r) { const float v = o1[db][r] - lam * (sa.o[db][r] * ia); o1[db][r] = v; ss += v * v; }
        ss += __shfl_xor(ss, 32);
        const float rstd = __builtin_amdgcn_rsqf(ss * (1.0f / 64.0f) + EPS) * oml;
        const float* sg = c.diff_subln_g + l * 64;
#pragma unroll
        for (int db = 0; db < 2; ++db)
#pragma unroll
            for (int gq = 0; gq < 4; ++gq) { const int d = 32 * db + 8 * gq + 4 * hi; const f32x4 gg = *(const f32x4*)(sg + d);
                u32x2 w; w.x = cvt_pk_bf16(o1[db][4 * gq] * rstd * gg.x, o1[db][4 * gq + 1] * rstd * gg.y); w.y = cvt_pk_bf16(o1[db][4 * gq + 2] * rstd * gg.z, o1[db][4 * gq + 3] * rstd * gg.w);
                *(u32x2*)(orow + d) = w; }
    }
}
__device__ __forceinline__ void p3_units(const Ctx& c0, int l, int qo = 0) {
    PHASE_CTX(c0);
    const int grp = c.blk & 7, jg = c.blk >> 3, nper = (c.nblk - grp + 7) >> 3;
    (void)qo;
#define P3_KIND(...) _Pragma("unroll 1") for (int f = jg; f < 32; f += nper) { _Pragma("unroll 1") for (int h2 = 0; h2 < 2; ++h2) { const int u = h2 ? 63 - f : f; __VA_ARGS__ } }
    P3_KIND({ const int bh = grp + 8 * (u & 3), qk = 15 - (u >> 2); if (ATT_DMA_MODES & 4) attn_unit<2>(c, l, bh >> 2, bh & 3, qk); else attn_unit_rs<2>(c, l, bh >> 2, bh & 3, qk); })
    P3_KIND({ const int bh = grp + 8 * (u & 3), qk = 15 - (u >> 2); if (ATT_DMA_MODES & 1) attn_unit<0>(c, l, bh >> 2, bh & 3, qk); else attn_unit_rs<0>(c, l, bh >> 2, bh & 3, qk); })
    P3_KIND({ if (ATT_DMA_MODES & 2) attn_unit<1>(c, l, grp, 0, 63 - u); else attn_unit_rs<1>(c, l, grp, 0, 63 - u); })
    P3_KIND({ const int bh = grp + 8 * (u & 3), qk = u >> 2; if (ATT_DMA_MODES & 8) attn_unit<3>(c, l, bh >> 2, bh & 3, qk); else attn_unit_rs<3>(c, l, bh >> 2, bh & 3, qk); })
#undef P3_KIND
}

__device__ __forceinline__ bf16_t* y_row(unsigned char* ws, float* dout, size_t tok) {
    return tok < (size_t)(T / 2) ? (bf16_t*)(ws + OFF_Z) + tok * 4096 : (bf16_t*)dout + (tok - T / 2) * 4096;
}
struct YOrder {
    int G, c;
    __device__ __forceinline__ bool next(int i, pg8::Unit& u) const { const int L = i * G + c; if (L >= 2048) return false; const int n = L >> 9, rem = L & 511; u.pm = n * 128 + (rem >> 2); u.pn = n * 4 + (rem & 3); return true; }
    __device__ __forceinline__ void a_ready(const pg8::Unit&) const {}
    __device__ __forceinline__ void done(const pg8::Unit&) const {}
};
struct EpiY {
    static constexpr bool PERM = false, AFTER_DRAIN = false;
    unsigned char* ws; float* dout;
    __device__ __forceinline__ void operator()(const f32x4 (&acc)[2][2][4][2], const pg8::Unit& u, int wr, int wc, int fr, int fq) const {
        { int ln_; asm volatile("v_mbcnt_lo_u32_b32 %0, -1, 0\n\tv_mbcnt_hi_u32_b32 %0, -1, %0" : "=v"(ln_)); fr = ln_ & 15; fq = ln_ >> 4; }
        const int n = u.pn >> 2, pnl = u.pn & 3, tt = u.pm - n * 128;
#pragma unroll
        for (int ai = 0; ai < 2; ++ai)
#pragma unroll
            for (int m = 0; m < 4; ++m) {
                const size_t tok = (size_t)tt * 256 + ai * 128 + wr * 64 + m * 16 + fr;
                bf16_t* yr = y_row(ws, dout, tok) + n * DM + pnl * 256 + wc * 32 + ((fq & 1) ? 16 + 4 * (fq - 1) : 4 * fq);
#pragma unroll
                for (int bj = 0; bj < 2; ++bj) { const f32x4 v0 = acc[ai][bj][m][0], v1 = acc[ai][bj][m][1];
                    unsigned a0 = cvt_pk_bf16(v0.x, v0.y), a1 = cvt_pk_bf16(v0.z, v0.w), b0 = cvt_pk_bf16(v1.x, v1.y), b1 = cvt_pk_bf16(v1.z, v1.w);
                    asm volatile("s_nop 1" : "+v"(a0), "+v"(a1), "+v"(b0), "+v"(b1));
                    const auto s0 = __builtin_amdgcn_permlane16_swap(a0, b0, false, false);
                    const auto s1 = __builtin_amdgcn_permlane16_swap(a1, b1, false, false);
                    u32x4 w; w.x = s0[0]; w.y = s1[0]; w.z = s0[1]; w.w = s1[1]; st16_wt(yr + bj * 128, w); }
            }
    }
};
__device__ __forceinline__ void p4a_units(const Ctx& c0) {
    PHASE_CTX(c0);
    pg8::Gemm g{WSP(bf16_t, OFF_O), WSP(bf16_t, OFF_WBT), 4 * T, 4096, 256}; YOrder S{c.nblk, c.blk};
    EpiY E{c.ws, c.out};
    pg8::gemm_phase<EpiY, YOrder, true, true>(c.lds, g, S, E, c.tid);
}
struct EpiGM {
    static constexpr bool PERM = false, AFTER_DRAIN = false;
    unsigned char* ws; float* dout; const float* bgate; const float* ss;
    __device__ __forceinline__ void operator()(const f32x4 (&acc)[2][2][4][2], const pg8::Unit& u, int wr, int wc, int fr, int fq) const {
        { int ln_; asm volatile("v_mbcnt_lo_u32_b32 %0, -1, 0\n\tv_mbcnt_hi_u32_b32 %0, -1, %0" : "=v"(ln_)); fr = ln_ & 15; fq = ln_ >> 4; }
        const int d4 = 64 * u.pn + 16 * wc + 4 * fq;
        f32x4 bg[4];
#pragma unroll
        for (int br = 0; br < 4; ++br) bg[br] = *(const f32x4*)(bgate + br * DM + d4);
        float rs8[2][4]; u32x2 yv[2][4][4];
#pragma unroll
        for (int ai = 0; ai < 2; ++ai)
#pragma unroll
            for (int m = 0; m < 4; ++m) {
                const size_t tok = (size_t)u.pm * 256 + ai * 128 + wr * 64 + m * 16 + fr;
                rs8[ai][m] = rs_row_coop(ss, tok, fq);
                const bf16_t* yr = y_row(ws, dout, tok) + d4;
#pragma unroll
                for (int br = 0; br < 4; ++br) yv[ai][m][br] = *(const u32x2*)(yr + br * DM);
            }
#pragma unroll
        for (int ai = 0; ai < 2; ++ai)
#pragma unroll
            for (int m2 = 0; m2 < 4; m2 += 2) {
                u32x2 wm[2];
#pragma unroll
                for (int mm = 0; mm < 2; ++mm) { const int m = m2 + mm;
                    const float rs = rs8[ai][m];
                    f32x4 o = (f32x4){0.f, 0.f, 0.f, 0.f};
#pragma unroll
                    for (int br = 0; br < 4; ++br) { const f32x4 a = acc[ai][br >> 1][m][br & 1];
#pragma unroll
                        for (int i = 0; i < 4; ++i) { const float z = a[i] * rs + bg[br][i]; const float gt = __builtin_amdgcn_rcpf(1.0f + fexp2(-LOG2E * z));
                            const unsigned w = (i >> 1) ? yv[ai][m][br].y : yv[ai][m][br].x; const float yf = __uint_as_float((i & 1) ? (w & 0xffff0000u) : (w << 16)); o[i] += gt * yf; } }
                    wm[mm].x = cvt_pk_bf16(o.x, o.y); wm[mm].y = cvt_pk_bf16(o.z, o.w); }
                asm volatile("s_nop 1" : "+v"(wm[0].x), "+v"(wm[0].y), "+v"(wm[1].x), "+v"(wm[1].y));
                const auto s0 = __builtin_amdgcn_permlane16_swap(wm[0].x, wm[1].x, false, false);
                const auto s1 = __builtin_amdgcn_permlane16_swap(wm[0].y, wm[1].y, false, false);
                u32x4 w; w.x = s0[0]; w.y = s1[0]; w.z = s0[1]; w.w = s1[1];
                const size_t tok = (size_t)u.pm * 256 + ai * 128 + wr * 64 + (m2 + (fq & 1)) * 16 + fr;
                st16_wt((bf16_t*)(ws + OFF_MRG) + tok * DM + 64 * u.pn + 16 * wc + 4 * (fq & 2), w);
            }
    }
};
__device__ __forceinline__ void p4b_units(const Ctx& c0, int l) {
    PHASE_CTX(c0);
    pg8::Gemm g{WSP(bf16_t, OFF_XB), WSP(bf16_t, OFF_WGT), T, 4096, DM}; pg8::StaticOrder S; S.init(T, 4096, c.nblk, c.blk);
    EpiGM E{c.ws, c.out, c.b_gate + (size_t)l * 4096, WSP(float, OFF_SS) + ss_off(2 * l)};
    pg8::gemm_phase<EpiGM, pg8::StaticOrder, true, true>(c.lds, g, S, E, c.tid);
}

struct EpiRes {
    static constexpr bool PERM = false, AFTER_DRAIN = false;
    const float* basef; float* Xout; bf16_t* XB; float* ss;
    __device__ __forceinline__ void operator()(const f32x4 (&acc)[2][2][4][2], const pg8::Unit& u, int wr, int wc, int fr, int fq) const {
        { int ln_; asm volatile("v_mbcnt_lo_u32_b32 %0, -1, 0\n\tv_mbcnt_hi_u32_b32 %0, -1, %0" : "=v"(ln_)); fr = ln_ & 15; fq = ln_ >> 4; }
#pragma unroll
        for (int ai = 0; ai < 2; ++ai) {
            f32x4 pre[4][2][2];
            if (basef) {
#pragma unroll
                for (int m = 0; m < 4; ++m) { const size_t tok = (size_t)u.pm * 256 + ai * 128 + wr * 64 + m * 16 + fr;
#pragma unroll
                    for (int bj = 0; bj < 2; ++bj)
#pragma unroll
                        for (int n = 0; n < 2; ++n) pre[m][bj][n] = *(const f32x4*)(basef + tok * DM + u.pn * 256 + bj * 128 + wc * 32 + n * 16 + 4 * fq); }
            } else {
                u32x2 pb[4][2][2];
#pragma unroll
                for (int m = 0; m < 4; ++m) { const size_t tok = (size_t)u.pm * 256 + ai * 128 + wr * 64 + m * 16 + fr;
#pragma unroll
                    for (int bj = 0; bj < 2; ++bj)
#pragma unroll
                        for (int n = 0; n < 2; ++n) pb[m][bj][n] = *(const u32x2*)(XB + tok * DM + u.pn * 256 + bj * 128 + wc * 32 + n * 16 + 4 * fq); }
#pragma unroll
                for (int m = 0; m < 4; ++m)
#pragma unroll
                    for (int bj = 0; bj < 2; ++bj)
#pragma unroll
                        for (int n = 0; n < 2; ++n) { const u32x2 w = pb[m][bj][n];
                            pre[m][bj][n] = (f32x4){__uint_as_float(w.x << 16), __uint_as_float(w.x & 0xffff0000u), __uint_as_float(w.y << 16), __uint_as_float(w.y & 0xffff0000u)}; }
            }
#pragma unroll
            for (int m = 0; m < 4; ++m) {
                const size_t tok = (size_t)u.pm * 256 + ai * 128 + wr * 64 + m * 16 + fr;
                float sq = 0.f;
#pragma unroll
                for (int bj = 0; bj < 2; ++bj) {
                    unsigned pk[2][2];
#pragma unroll
                    for (int n = 0; n < 2; ++n) { const size_t off = tok * DM + u.pn * 256 + bj * 128 + wc * 32 + n * 16 + 4 * fq;
                        const f32x4 o = pre[m][bj][n] + acc[ai][bj][m][n];
                        if (Xout) *(f32x4*)(Xout + off) = o;
                        pk[n][0] = cvt_pk_bf16(o.x, o.y); pk[n][1] = cvt_pk_bf16(o.z, o.w);
                        sq += (o.x * o.x + o.y * o.y) + (o.z * o.z + o.w * o.w); }
                    asm volatile("s_nop 1" : "+v"(pk[0][0]), "+v"(pk[0][1]), "+v"(pk[1][0]), "+v"(pk[1][1]));
                    const auto s0 = __builtin_amdgcn_permlane16_swap(pk[0][0], pk[1][0], false, false);
                    const auto s1 = __builtin_amdgcn_permlane16_swap(pk[0][1], pk[1][1], false, false);
                    u32x4 w; w.x = s0[0]; w.y = s1[0]; w.z = s0[1]; w.w = s1[1];
                    st16_wt(XB + tok * DM + u.pn * 256 + bj * 128 + wc * 32 + ((fq & 1) ? 16 + 4 * (fq - 1) : 4 * fq), w); }
                sq += __shfl_xor(sq, 16); sq += __shfl_xor(sq, 32);
                if (fq == 0) ss[tok * 16 + u.pn * 4 + wc] = sq;
            }
        }
    }
};
__device__ __forceinline__ void resid_gemm(const Ctx& c0, const bf16_t* A, int K, const bf16_t* Bt, bool from_input, bool write_x, int ssidx) {
    PHASE_CTX(c0);
    pg8::Gemm g{A, Bt, T, DM, K}; pg8::StaticOrder S; S.init(T, DM, c.nblk, c.blk);
    EpiRes E{from_input ? c.x : (const float*)nullptr, write_x ? WSP(float, OFF_X) : (float*)nullptr, WSP(bf16_t, OFF_XB), WSP(float, OFF_SS) + ss_off(ssidx)};
    pg8::gemm_phase<EpiRes, pg8::StaticOrder, true, true>(c.lds, g, S, E, c.tid);
}
struct EpiSw {
    static constexpr bool PERM = true, AFTER_DRAIN = false;
    bf16_t* AF; const float* ss;
    __device__ __forceinline__ void operator()(const f32x4 (&acc)[2][2][4][2], const pg8::Unit& u, int wr, int wc, int fr, int fq) const {
        { int ln_; asm volatile("v_mbcnt_lo_u32_b32 %0, -1, 0\n\tv_mbcnt_hi_u32_b32 %0, -1, %0" : "=v"(ln_)); fr = ln_ & 15; fq = ln_ >> 4; }
        float rs8[2][4];
#pragma unroll
        for (int ai = 0; ai < 2; ++ai)
#pragma unroll
            for (int m = 0; m < 4; ++m) rs8[ai][m] = rs_row_coop(ss, (size_t)u.pm * 256 + ai * 128 + wr * 64 + m * 16 + fr, fq);
#pragma unroll
        for (int ai = 0; ai < 2; ++ai)
#pragma unroll
            for (int m = 0; m < 4; ++m) {
                const size_t tok = (size_t)u.pm * 256 + ai * 128 + wr * 64 + m * 16 + fr;
                const float rs = rs8[ai][m], rsl = -LOG2E * rs;
                u32x4 w;
#pragma unroll
                for (int n = 0; n < 2; ++n) { f32x4 o;
#pragma unroll
                    for (int i = 0; i < 4; ++i) { const float ga = acc[ai][0][m][n][i], ua = acc[ai][1][m][n][i]; o[i] = (ga * rs) * __builtin_amdgcn_rcpf(1.0f + fexp2(ga * rsl)) * (ua * rs); }
                    if (n == 0) { w.x = cvt_pk_bf16(o.x, o.y); w.y = cvt_pk_bf16(o.z, o.w); } else { w.z = cvt_pk_bf16(o.x, o.y); w.w = cvt_pk_bf16(o.z, o.w); } }
                st16_wt(AF + tok * FF + u.pn * 128 + wc * 32 + 8 * fq, w);
            }
    }
};
__device__ __forceinline__ void p6_units(const Ctx& c0, int l) {
    PHASE_CTX(c0);
    pg8::Gemm g{WSP(bf16_t, OFF_XB), WSP(bf16_t, OFF_WF1T), T, 2 * FF, DM}; pg8::StaticOrder S; S.init(T, 2 * FF, c.nblk, c.blk);
    EpiSw E{WSP(bf16_t, OFF_AF), WSP(float, OFF_SS) + ss_off(2 * l + 1)};
    pg8::gemm_phase<EpiSw, pg8::StaticOrder, true, true>(c.lds, g, S, E, c.tid);
}

constexpr int NSTEP = 2 + 8 * DEPTH;
__global__ void __launch_bounds__(NTHREADS, 2) trunk_fwd(Params p) {
    extern __shared__ __attribute__((aligned(16))) unsigned char lds_raw[];
    Ctx c;
    c.x = nullptr; c.mem = nullptr; c.pos = nullptr; c.norm_mix_g = nullptr; c.w_in = nullptr; c.b_forget = nullptr; c.diff_lambda = nullptr; c.diff_subln_g = nullptr; c.norm_mem_g = nullptr; c.w_mem_kv = nullptr;
    c.w_branch = nullptr; c.w_gate = nullptr; c.b_gate = nullptr; c.w_out = nullptr; c.norm_ffn_g = nullptr; c.w_ffn_in = nullptr; c.w_ffn_out = nullptr; c.final_norm_g = nullptr;
    c.out = nullptr; c.ws = p.ws; c.lds = (LAS unsigned char*)lds_raw; c.tid = threadIdx.x; c.lane = c.tid & 63; c.wid = __builtin_amdgcn_readfirstlane(c.tid >> 6);
    c.nblk = gridDim.x; c.blk = blockIdx.x;
    if (c.tid < 64) ((LAS unsigned*)(c.lds + LDS_CTL))[c.tid] = 0u;
    __syncthreads();
    XcdBarrier bar; bar.bar = WSP(unsigned, OFF_CTL) + CW_BAR; bar.x = 0; bar.st = nullptr;
    const bool multi = (p.s_hi - p.s_lo) > 1;
    if (multi) bar = xcd_barrier_post(WSP(unsigned, OFF_CTL) + CW_BAR, (volatile LAS unsigned*)(c.lds + LDS_CTL));
#define STEP_ON(s) (p.s_lo <= (s) && (s) < p.s_hi)
#define STEP_SYNC(s) do { if ((s) + 1 < p.s_hi) xcd_barrier(bar, c.wid); } while (0)
    if (STEP_ON(0)) { prologue(c); STEP_SYNC(0); }
    for (int l = 0; l < DEPTH; ++l) {
        const int sb = 1 + 8 * l;
        if (STEP_ON(sb + 0)) { p1_units(c, l); STEP_SYNC(sb + 0); }
        if (STEP_ON(sb + 1)) {
_Pragma("unroll 1") for (int rep = 0; rep < (PROBE_DUP == 2 ? 2 : 1); ++rep) p2_units(c, l, 8 * rep);
 if (l > 0) prep_ffn(c, l); STEP_SYNC(sb + 1); }
        if (STEP_ON(sb + 2)) {
_Pragma("unroll 1") for (int rep = 0; rep < (PROBE_DUP == 3 ? 2 : 1); ++rep) p3_units(c, l, 8 * rep);
 STEP_SYNC(sb + 2); }
        if (STEP_ON(sb + 3)) {
_Pragma("unroll 1") for (int rep = 0; rep < (PROBE_DUP == 4 ? 2 : 1); ++rep) p4a_units(c);
 STEP_SYNC(sb + 3); }
        if (STEP_ON(sb + 4)) {
_Pragma("unroll 1") for (int rep = 0; rep < (PROBE_DUP == 5 ? 2 : 1); ++rep) p4b_units(c, l);
 STEP_SYNC(sb + 4); }
        if (STEP_ON(sb + 5)) { resid_gemm(c, WSP(bf16_t, OFF_MRG), DM, WSP(bf16_t, OFF_WOT), l == 0, false, 2 * l + 1); STEP_SYNC(sb + 5); }
        if (STEP_ON(sb + 6)) {
_Pragma("unroll 1") for (int rep = 0; rep < (PROBE_DUP == 6 ? 2 : 1); ++rep) p6_units(c, l);
 if (l + 1 < DEPTH) prep_mixer(c, l + 1);
 STEP_SYNC(sb + 6); }
        if (STEP_ON(sb + 7)) { resid_gemm(c, WSP(bf16_t, OFF_AF), FF, WSP(bf16_t, OFF_WF2T), false, l == DEPTH - 1, 2 * l + 2); STEP_SYNC(sb + 7); }
    }
    if (STEP_ON(NSTEP - 1)) final_norm(c);
}

extern "C" void kernel_launch(void* const* d_in, const int* in_sizes, int n_in, void* d_out, int out_size, void* d_ws, size_t ws_size, hipStream_t stream) {
    static int grid = 0;
    if (grid == 0) {
        if (n_in != 18 || out_size != T * DM || ws_size < WS_END) { fprintf(stderr, "kernel_launch: unexpected shapes (n_in %d out %d ws %zu)\n", n_in, out_size, ws_size); grid = -1; return; }
        int dev = 0, cus = 0, per_cu = 0;
        if (hipGetDevice(&dev) != hipSuccess || hipDeviceGetAttribute(&cus, hipDeviceAttributeMultiprocessorCount, dev) != hipSuccess) { grid = -1; return; }
        if (hipFuncSetAttribute((const void*)trunk_fwd, hipFuncAttributeMaxDynamicSharedMemorySize, LDS_BYTES) != hipSuccess) { grid = -1; return; }
        if (hipOccupancyMaxActiveBlocksPerMultiprocessor(&per_cu, (const void*)trunk_fwd, NTHREADS, LDS_BYTES) != hipSuccess || per_cu < 1) { fprintf(stderr, "kernel_launch: occupancy query says %d\n", per_cu); }
        (void)hipGetLastError();
        grid = cus;
    }
    if (grid < 0) return;
    (void)hipMemsetAsync((char*)d_ws + OFF_CTL, 0, ZERO_BYTES, stream);
    Params p{};
    for (int i = 0; i < 18; ++i) p.in[i] = (const float*)d_in[i];
    p.out = (float*)d_out; p.ws = (unsigned char*)d_ws;
#if MK_ONE_LAUNCH
    p.s_lo = 0; p.s_hi = NSTEP;
    hipLaunchKernelGGL(trunk_fwd, dim3(grid), dim3(NTHREADS), LDS_BYTES, stream, p);
#else
    for (int s = 0; s < NSTEP; ++s) { p.s_lo = s; p.s_hi = s + 1; hipLaunchKernelGGL(trunk_fwd, dim3(grid), dim3(NTHREADS), LDS_BYTES, stream, p); }
#endif
}
```

```cpp
#include <hip/hip_runtime.h>
#include <cstdint>
#include <cstdio>
#include <cmath>

#ifndef PROBE_DUP
#define PROBE_DUP 0
#endif
#ifndef ATT_DMA_MODES
#define ATT_DMA_MODES 15
#endif
#ifndef MK_ONE_LAUNCH
#define MK_ONE_LAUNCH 1
#endif

#define GAS __attribute__((address_space(1)))
#define LAS __attribute__((address_space(3)))
typedef unsigned short bf16_t;
typedef short bf16x8 __attribute__((ext_vector_type(8)));
typedef short v4i16_t __attribute__((ext_vector_type(4)));
typedef float f32x4 __attribute__((ext_vector_type(4)));
typedef float f32x16 __attribute__((ext_vector_type(16)));
typedef unsigned u32x4 __attribute__((ext_vector_type(4)));
typedef unsigned u32x2 __attribute__((ext_vector_type(2)));
typedef GAS unsigned gu32;

constexpr int NB = 8, SEQ = 4096, T = NB * SEQ, DM = 1024, DEPTH = 4, MEML = 256, FF = 2816, INC = 2476;
constexpr int ZP = 2560;
constexpr float EPS = 1e-6f;
constexpr float LOG2E = 1.4426950408889634f;
constexpr int NTHREADS = 512;

constexpr size_t MiB = 1u << 20;
constexpr size_t OFF_CTL = 0, CTL_BYTES = 256 * 1024;
constexpr size_t ZERO_BYTES = CTL_BYTES;
constexpr size_t OFF_W1T = 2 * MiB;
constexpr size_t OFF_WGT = OFF_W1T + 5 * MiB;
constexpr size_t OFF_WBT = OFF_WGT + 8 * MiB;
constexpr size_t OFF_WOT = OFF_WBT + 2 * MiB;
constexpr size_t OFF_WF1T = OFF_WOT + 2 * MiB;
constexpr size_t OFF_WF2T = OFF_WF1T + 11 * MiB;
constexpr size_t OFF_WMEMT = OFF_WF2T + 6 * MiB;
constexpr size_t OFF_MEMB = OFF_WMEMT + 4 * MiB;
constexpr size_t OFF_MEMKV = OFF_MEMB + 4 * MiB;
constexpr size_t OFF_MISC = OFF_MEMKV + 8 * MiB;
constexpr size_t OFF_CS16 = OFF_MISC + 1 * MiB;
constexpr size_t OFF_CS8 = OFF_CS16 + 2 * MiB;
constexpr size_t OFF_SS = OFF_CS8 + 1 * MiB;
constexpr size_t OFF_FL = OFF_SS + 4 * MiB;
constexpr size_t OFF_CUM = OFF_FL + 1 * MiB;
constexpr size_t OFF_WI = OFF_CUM + 1 * MiB;
constexpr size_t OFF_MASK = OFF_WI + 1 * MiB;
constexpr size_t OFF_X = OFF_MASK + 16 * MiB;
constexpr size_t OFF_XB = OFF_X + 128 * MiB;
constexpr size_t OFF_Z = OFF_XB + 64 * MiB;
constexpr size_t OFF_O = OFF_Z + 160 * MiB;
constexpr size_t WS_END = OFF_O + 64 * MiB;
constexpr size_t OFF_MRG = OFF_Z + 128 * MiB;
constexpr size_t OFF_AF = OFF_Z;
static_assert((size_t)T * FF * 2 <= 224 * MiB, "AF fits Z|O");
static_assert(ZERO_BYTES <= 2 * MiB && WS_END <= 512 * MiB, "workspace map");

constexpr int CW_BAR = 4096;
constexpr int CW_Q = 16384;

constexpr int LDS_MAIN = 131072;
constexpr int LDS_CTL = LDS_MAIN;
constexpr int LDS_BYTES = 132096;

typedef __bf16 bf16pair_t __attribute__((ext_vector_type(2)));
typedef float f32x2 __attribute__((ext_vector_type(2)));
__device__ __forceinline__ unsigned cvt_pk_bf16(float lo, float hi) { unsigned r; asm("v_cvt_pk_bf16_f32 %0, %1, %2" : "=v"(r) : "v"(lo), "v"(hi)); return r; }
__device__ __forceinline__ unsigned cvt_pk_bf16_c(float lo, float hi) { return __builtin_bit_cast(unsigned, __builtin_convertvector((f32x2){lo, hi}, bf16pair_t)); }
__device__ __forceinline__ void st16_wt(void* p, u32x4 v) { *(u32x4*)p = v; }
__device__ __forceinline__ float wave_sum(float v) {
#pragma unroll
    for (int o = 1; o < 64; o <<= 1) v += __shfl_xor(v, o);
    return v;
}
__device__ __forceinline__ float fexp2(float x) { return __builtin_amdgcn_exp2f(x); }

#define XB_TMO      128
#define XB_XCNT(j)  (256  + 64 * (j))
#define XB_XSUB(j)  (1280 + 64 * (j))
#define XB_XGEN(j)  (2304 + 64 * (j))
#define XB_TOP      3328
#define XB_TOPGEN   3392
#define XCD_BAR_WORDS 3456
#define XB_SPIN_CAP (1u << 22)
__device__ __forceinline__ unsigned xb_ld(unsigned* p)              { return __hip_atomic_load(p, __ATOMIC_RELAXED, __HIP_MEMORY_SCOPE_AGENT); }
__device__ __forceinline__ unsigned xb_add(unsigned* p, unsigned v) { return __hip_atomic_fetch_add(p, v, __ATOMIC_RELAXED, __HIP_MEMORY_SCOPE_AGENT); }
__device__ __forceinline__ unsigned xb_xcc_id() { return (unsigned)__builtin_amdgcn_s_getreg((3 << 11) | 20) & 0xFu; }
#define XB_SPIN(cond, bar) do { unsigned _sp = 0; while (cond) { __builtin_amdgcn_s_sleep(1); \
    if ((++_sp & 255u) == 0u) { if (xb_ld(&(bar)[XB_TMO])) break; if (_sp > XB_SPIN_CAP) { atomicAdd(&(bar)[XB_TMO], 1u); break; } } } } while (0)
struct XcdBarrier { unsigned* bar; unsigned x; volatile LAS unsigned* st; };
__device__ __forceinline__ XcdBarrier xcd_barrier_post(unsigned* bar, volatile LAS unsigned* st) {
    XcdBarrier b; b.bar = bar; b.x = xb_xcc_id(); b.st = st;
    if (threadIdx.x == 0) (void)xb_add(&bar[XB_XCNT(b.x)], 1u);
    return b;
}
__device__ __forceinline__ void xcd_barrier_complete(unsigned* bar, unsigned x, unsigned& nloc, unsigned& nx) {
    const unsigned G = gridDim.x * gridDim.y * gridDim.z;
    unsigned sum, cnt, mine, sp = 0u;
    for (;;) {
        sum = 0u; cnt = 0u; mine = 0u;
#pragma unroll
        for (unsigned j = 0; j < 16; ++j) { const unsigned c = xb_ld(&bar[XB_XCNT(j)]); sum += c; cnt += (c > 0u) ? 1u : 0u; mine = (j == x) ? c : mine; }
        if (sum == G) break;
        __builtin_amdgcn_s_sleep(1);
        if ((++sp & 255u) == 0u) { if (xb_ld(&bar[XB_TMO])) break; if (sp > XB_SPIN_CAP) { atomicAdd(&bar[XB_TMO], 1u); break; } }
    }
    nloc = mine > 0u ? mine : 1u; nx = cnt > 0u ? cnt : 1u;
}
__device__ __forceinline__ void xcd_barrier(const XcdBarrier& b, int wid) {
    asm volatile("s_waitcnt vmcnt(0)" ::: "memory");
    __syncthreads();
    int ln0_; asm volatile("v_mbcnt_lo_u32_b32 %0, -1, 0\n\tv_mbcnt_hi_u32_b32 %0, -1, %0" : "=v"(ln0_));
    if (wid == 0 && ln0_ == 0) {
        unsigned* bar = b.bar;
        __builtin_amdgcn_s_waitcnt(0);
        unsigned nloc = b.st[0], nx = b.st[1];
        if (nloc == 0u) { xcd_barrier_complete(bar, b.x, nloc, nx); b.st[0] = nloc; b.st[1] = nx; }
        const unsigned old = xb_add(&bar[XB_XSUB(b.x)], 1u);
        const unsigned gen = old / nloc;
        if (old + 1u == (gen + 1u) * nloc) {
            __builtin_amdgcn_fence(__ATOMIC_RELEASE, "agent");
            asm volatile("s_waitcnt vmcnt(0)" ::: "memory");
            const unsigned og = xb_add(&bar[XB_TOP], 1u);
            const unsigned tg = og / nx;
            if (og + 1u == (tg + 1u) * nx) xb_add(&bar[XB_TOPGEN], 1u);
            else XB_SPIN(xb_ld(&bar[XB_TOPGEN]) == tg, bar);
            __builtin_amdgcn_fence(__ATOMIC_ACQUIRE, "agent");
            xb_add(&bar[XB_XGEN(b.x)], 1u);
            asm volatile("s_waitcnt vmcnt(0)" ::: "memory");
        } else {
            XB_SPIN(xb_ld(&bar[XB_XGEN(b.x)]) == gen, bar);
            __builtin_amdgcn_fence(__ATOMIC_ACQUIRE, "agent");
            asm volatile("s_waitcnt vmcnt(0)" ::: "memory");
        }
    }
    __syncthreads();
}

struct Params {
    const float* in[18]; float* out; unsigned char* ws; int s_lo, s_hi;
};
struct Ctx {
    const float *x, *mem; const int* pos;
    const float *norm_mix_g, *w_in, *b_forget, *diff_lambda, *diff_subln_g, *norm_mem_g, *w_mem_kv, *w_branch, *w_gate, *b_gate, *w_out, *norm_ffn_g, *w_ffn_in, *w_ffn_out, *final_norm_g;
    float* out; unsigned char* ws; LAS unsigned char* lds; int tid, lane, wid; int nblk, blk;
};
#define WSP(type, off) ((type*)(c.ws + (off)))
#define PHASE_CTX(c0) Ctx c = (c0); { int wv_ = c.wid; asm volatile("" : "+s"(wv_)); int ln_; asm volatile("v_mbcnt_lo_u32_b32 %0, -1, 0\n\tv_mbcnt_hi_u32_b32 %0, -1, %0" : "=v"(ln_)); \
    c.wid = wv_; c.lane = ln_; c.tid = wv_ * 64 + ln_; \
    GAS unsigned char* w_ = (GAS unsigned char*)c.ws; asm volatile("" : "+s"(w_)); c.ws = (unsigned char*)w_; \
      \
    const __attribute__((address_space(4))) Params* kp_ = (const __attribute__((address_space(4))) Params*)__builtin_amdgcn_kernarg_segment_ptr(); asm volatile("" : "+s"(kp_)); \
    c.x = kp_->in[0]; c.mem = kp_->in[1]; c.pos = (const int*)kp_->in[2]; c.norm_mix_g = kp_->in[3]; c.w_in = kp_->in[4]; c.b_forget = kp_->in[5]; c.diff_lambda = kp_->in[6]; c.diff_subln_g = kp_->in[7]; \
    c.norm_mem_g = kp_->in[8]; c.w_mem_kv = kp_->in[9]; c.w_branch = kp_->in[10]; c.w_gate = kp_->in[11]; c.b_gate = kp_->in[12]; c.w_out = kp_->in[13]; c.norm_ffn_g = kp_->in[14]; c.w_ffn_in = kp_->in[15]; \
    c.w_ffn_out = kp_->in[16]; c.final_norm_g = kp_->in[17]; c.out = kp_->out; }

__device__ __forceinline__ int q_next(const Ctx& c, int qid) {
    volatile LAS unsigned* slot = (volatile LAS unsigned*)(c.lds + LDS_CTL + 64);
    __syncthreads();
    if (c.tid == 0) slot[0] = __hip_atomic_fetch_add(WSP(unsigned, OFF_CTL) + CW_Q + 64 * qid, 1u, __ATOMIC_RELAXED, __HIP_MEMORY_SCOPE_AGENT);
    __syncthreads();
    return (int)slot[0];
}

__device__ __forceinline__ int sw_off(int row, int ch) { return row * 128 + ((ch ^ ((row >> 1) & 7)) << 4); }
__device__ __forceinline__ void gemm_tile(f32x4 (&acc)[4][2], const bf16_t* A, int lda, const bf16_t* Bt, int ldb, int K, LAS unsigned char* lds, int tid) {
    const int wid = tid >> 6, lane = tid & 63, fr = lane & 15, fq = lane >> 4, wr = wid >> 2, wc = wid & 3;
    const int srow = tid >> 3, sch = tid & 7;
    const bf16_t* ga = A + (size_t)srow * lda + sch * 8;
    const bf16_t* gb = Bt + (size_t)srow * ldb + sch * 8;
    const size_t a64 = (size_t)64 * lda, b64 = (size_t)64 * ldb;
    const int so0 = sw_off(srow, sch), so1 = sw_off(srow + 64, sch);
    u32x4 ra0 = *(const u32x4*)ga, ra1 = *(const u32x4*)(ga + a64), rb0 = *(const u32x4*)gb, rb1 = *(const u32x4*)(gb + b64);
    *(LAS u32x4*)(lds + so0) = ra0; *(LAS u32x4*)(lds + so1) = ra1; *(LAS u32x4*)(lds + 16384 + so0) = rb0; *(LAS u32x4*)(lds + 16384 + so1) = rb1;
    __syncthreads();
    const int nk = K >> 6;
    for (int kt = 0; kt < nk; ++kt) {
        const int cur = (kt & 1) * 32768, nxt = cur ^ 32768;
        const bool more = kt + 1 < nk;
        if (more) { const int ko = (kt + 1) * 64; ra0 = *(const u32x4*)(ga + ko); ra1 = *(const u32x4*)(ga + a64 + ko); rb0 = *(const u32x4*)(gb + ko); rb1 = *(const u32x4*)(gb + b64 + ko); }
#pragma unroll
        for (int kk = 0; kk < 2; ++kk) {
            bf16x8 af[4], bv[2];
#pragma unroll
            for (int m = 0; m < 4; ++m) af[m] = *(const LAS bf16x8*)(lds + cur + sw_off(wr * 64 + m * 16 + fr, kk * 4 + fq));
#pragma unroll
            for (int n = 0; n < 2; ++n) bv[n] = *(const LAS bf16x8*)(lds + cur + 16384 + sw_off(wc * 32 + n * 16 + fr, kk * 4 + fq));
#pragma unroll
            for (int m = 0; m < 4; ++m)
#pragma unroll
                for (int n = 0; n < 2; ++n) acc[m][n] = __builtin_amdgcn_mfma_f32_16x16x32_bf16(bv[n], af[m], acc[m][n], 0, 0, 0);
        }
        if (more) { *(LAS u32x4*)(lds + nxt + so0) = ra0; *(LAS u32x4*)(lds + nxt + so1) = ra1; *(LAS u32x4*)(lds + nxt + 16384 + so0) = rb0; *(LAS u32x4*)(lds + nxt + 16384 + so1) = rb1; }
        __syncthreads();
    }
}
__device__ __forceinline__ void acc_zero(f32x4 (&acc)[4][2]) {
#pragma unroll
    for (int m = 0; m < 4; ++m)
#pragma unroll
        for (int n = 0; n < 2; ++n) acc[m][n] = (f32x4){0.f, 0.f, 0.f, 0.f};
}

namespace pg8 {
#define PG8_LAS __attribute__((address_space(3)))
typedef unsigned short bf16_t;
typedef short bf16x8 __attribute__((ext_vector_type(8)));
typedef float f32x4 __attribute__((ext_vector_type(4)));
typedef unsigned u32x4 __attribute__((ext_vector_type(4)));
constexpr int BM = 256, BK = 64, HALF = 128, HTB = HALF * BK * 2  , STAGE_BYTES = 8 * HTB, NXCD = 8, WGM = 8;

__host__ __device__ __forceinline__ int lds_byte(int r, int c) { const int st = (r >> 4) * 2 + (c >> 5), rr = r & 15, cc = c & 31, ob = rr * 64 + cc * 2; return st * 1024 + (ob ^ (((ob >> 9) & 1) << 5)); }
__host__ __device__ __forceinline__ void stage_rc(int b, int& R, int& C) { const int st = b / 1024, sb = b % 1024, swz = sb ^ (((sb >> 9) & 1) << 5); R = (st >> 1) * 16 + swz / 64; C = (st & 1) * 32 + (swz % 64) / 2; }
__host__ __device__ __forceinline__ int perm32(int rho) { const int n = rho >> 4, i = rho & 15; return 8 * (i >> 2) + 4 * n + (i & 3); }

struct Unit { int pm, pn; };
struct Gemm { const bf16_t* A; const bf16_t* Bt; int M, N, K; };

struct StaticOrder {
    int nM, nN, nwg, G, c;
    __host__ __device__ void init(int M, int N, int G_, int c_) { nM = M / BM; nN = N / BM; nwg = nM * nN; G = G_; c = c_; }
    __host__ __device__ bool next(int i, Unit& u) const {
        const long L = (long)i * G + c; if (L >= nwg) return false;
        int wgid = (int)L; { const int q = nwg / NXCD, r = nwg % NXCD, xcd = wgid % NXCD, off = wgid / NXCD; wgid = (xcd < r ? xcd * (q + 1) : r * (q + 1) + (xcd - r) * q) + off; }
        const int nig = WGM * nN, gid = wgid / nig, fm = gid * WGM, gsz = (nM - fm) < WGM ? (nM - fm) : WGM;
        u.pm = fm + ((wgid % nig) % gsz); u.pn = (wgid % nig) / gsz; return true;
    }
    __device__ __forceinline__ void a_ready(const Unit&) const {}
    __device__ __forceinline__ void done(const Unit&) const {}
};

template <class Epi, class Sched, bool ALIGN_EPI = false, bool SP2 = false>
__device__ __forceinline__ void gemm_phase(PG8_LAS unsigned char* lds, const Gemm g, const Sched& S, const Epi& E, const int tid) {
    const int wid = __builtin_amdgcn_readfirstlane(tid >> 6), lane = tid & 63, wr = wid >> 2, wc = wid & 3, fr = lane & 15, fq = lane >> 4;
    const int K = g.K, nt = K / BK;
    unsigned voffA[2], voffB[2];
#pragma unroll
    for (int i = 0; i < 2; ++i) { int R, C; stage_rc(tid * 16 + i * 8192, R, C); const int Rb = Epi::PERM ? ((R & ~31) + perm32(R & 31)) : R;
        voffA[i] = (unsigned)(R * K + C) * 2u; voffB[i] = (unsigned)(Rb * K + C) * 2u; }
    const size_t kstep = (size_t)(BK * 2);
    const size_t hstep = (size_t)HALF * K * 2;
    const size_t tstep = 2 * hstep;
    const unsigned ldsw = (unsigned)wid * 1024u;
    const int aoff = lds_byte(wr * 64 + fr, fq * 8), boff = lds_byte(wc * 32 + fr, fq * 8);
#define PG8_SA(b, h) (((b) * 2 + (h)) * HTB)
#define PG8_SB(b, h) ((4 + (b) * 2 + (h)) * HTB)
#define PG8_STAGE(bufoff, gbase, voff) do { _Pragma("unroll") for (int _i = 0; _i < 2; ++_i) \
        __builtin_amdgcn_global_load_lds((const unsigned*)((const char*)(gbase) + (voff)[_i]), (PG8_LAS unsigned*)(lds + (bufoff) + ldsw + _i * 8192), 16, 0, 0); } while (0)
#define PG8_LDA(dst, b, h) do { _Pragma("unroll") for (int m = 0; m < 4; ++m) _Pragma("unroll") for (int k = 0; k < 2; ++k) dst[m][k] = *(const PG8_LAS bf16x8*)(lds + PG8_SA(b, h) + aoff + m * 2048 + k * 1024); } while (0)
#define PG8_LDB(dst, b, h) do { _Pragma("unroll") for (int n = 0; n < 2; ++n) _Pragma("unroll") for (int k = 0; k < 2; ++k) dst[n][k] = *(const PG8_LAS bf16x8*)(lds + PG8_SB(b, h) + boff + n * 2048 + k * 1024); } while (0)
#define PG8_MMA(ai, bj, At, Bt) do { __builtin_amdgcn_s_setprio(1); _Pragma("unroll") for (int m = 0; m < 4; ++m) _Pragma("unroll") for (int n = 0; n < 2; ++n) _Pragma("unroll") for (int k = 0; k < 2; ++k) \
        acc[ai][bj][m][n] = __builtin_amdgcn_mfma_f32_16x16x32_bf16(Bt[n][k], At[m][k], acc[ai][bj][m][n], 0, 0, 0); __builtin_amdgcn_s_setprio(0); } while (0)
#define PG8_WAIT_V(n) asm volatile("s_waitcnt vmcnt(" #n ")" ::: "memory")
#define PG8_WAIT_L(n) asm volatile("s_waitcnt lgkmcnt(" #n ")" ::: "memory")
#define PG8_BAR __builtin_amdgcn_s_barrier()
#define PG8_SCHED __builtin_amdgcn_sched_barrier(0)
    Unit cur, nxt; int ui = 0;
    if (!S.next(0, cur)) return;
    f32x4 acc[2][2][4][2];
#pragma unroll
    for (int a = 0; a < 2; ++a)
#pragma unroll
        for (int b = 0; b < 2; ++b)
#pragma unroll
            for (int m = 0; m < 4; ++m)
#pragma unroll
                for (int n = 0; n < 2; ++n) acc[a][b][m][n] = (f32x4){0.f, 0.f, 0.f, 0.f};
    bf16x8 At[4][2], B0[2][2], B1[2][2];
    const char* cA = (const char*)g.A + (size_t)cur.pm * tstep; const char* cB = (const char*)g.Bt + (size_t)cur.pn * tstep;
    S.a_ready(cur);
    if constexpr (SP2) {
        PG8_STAGE(PG8_SB(0, 0), cB, voffB); PG8_STAGE(PG8_SB(0, 1), cB + hstep, voffB); PG8_STAGE(PG8_SA(0, 0), cA, voffA); PG8_STAGE(PG8_SA(0, 1), cA + hstep, voffA);
        if (wr == 1) PG8_BAR;
        PG8_WAIT_V(2); PG8_BAR;
        PG8_STAGE(PG8_SB(1, 0), cB + kstep, voffB); PG8_STAGE(PG8_SA(1, 0), cA + kstep, voffA); PG8_STAGE(PG8_SB(1, 1), cB + hstep + kstep, voffB);
        PG8_WAIT_V(6); PG8_BAR;
    } else {
        PG8_STAGE(PG8_SB(0, 0), cB, voffB); PG8_STAGE(PG8_SA(0, 0), cA, voffA); PG8_STAGE(PG8_SB(0, 1), cB + hstep, voffB); PG8_STAGE(PG8_SA(0, 1), cA + hstep, voffA);
        if (wr == 1) PG8_BAR;
        PG8_WAIT_V(4); PG8_BAR;
        PG8_STAGE(PG8_SB(1, 0), cB + kstep, voffB); PG8_STAGE(PG8_SA(1, 0), cA + kstep, voffA); PG8_STAGE(PG8_SB(1, 1), cB + hstep + kstep, voffB);
        PG8_WAIT_V(6); PG8_BAR;
    }
    for (;;) {
        const bool has_next = S.next(ui + 1, nxt);
        const char* nA = has_next ? (const char*)g.A + (size_t)nxt.pm * tstep : cA; const char* nB = has_next ? (const char*)g.Bt + (size_t)nxt.pn * tstep : cB;
        for (int t = 0; t < nt; t += 2) {
            const bool last = (t == nt - 2);
            const char* a1 = cA + (size_t)(t + 1) * kstep;
            const char* a2 = last ? nA : cA + (size_t)(t + 2) * kstep; const char* b2 = last ? nB : cB + (size_t)(t + 2) * kstep;
            const char* a3 = a2 + kstep; const char* b3 = b2 + kstep;
            if (last && has_next) S.a_ready(nxt);
            if constexpr (SP2) {
            PG8_LDB(B0, 0, 0); PG8_LDB(B1, 0, 1); PG8_SCHED; PG8_LDA(At, 0, 0); PG8_STAGE(PG8_SA(1, 1), a1 + hstep, voffA);
            PG8_WAIT_V(8); PG8_WAIT_L(0); PG8_BAR; PG8_MMA(0, 0, At, B0); PG8_MMA(0, 1, At, B1); PG8_BAR; PG8_SCHED;
            PG8_LDA(At, 0, 1); PG8_STAGE(PG8_SB(0, 0), b2, voffB); PG8_STAGE(PG8_SB(0, 1), b2 + hstep, voffB); PG8_STAGE(PG8_SA(0, 0), a2, voffA);
            PG8_WAIT_V(8); PG8_WAIT_L(0); PG8_BAR; PG8_MMA(1, 0, At, B0); PG8_MMA(1, 1, At, B1); PG8_BAR; PG8_SCHED;
            PG8_LDB(B0, 1, 0); PG8_LDB(B1, 1, 1); PG8_SCHED; PG8_LDA(At, 1, 0); PG8_STAGE(PG8_SA(0, 1), a2 + hstep, voffA);
            PG8_WAIT_V(8); PG8_WAIT_L(0); PG8_BAR; PG8_MMA(0, 0, At, B0); PG8_MMA(0, 1, At, B1); PG8_BAR; PG8_SCHED;
            PG8_LDA(At, 1, 1); PG8_STAGE(PG8_SB(1, 0), b3, voffB); PG8_STAGE(PG8_SB(1, 1), b3 + hstep, voffB); PG8_STAGE(PG8_SA(1, 0), a3, voffA);
            PG8_WAIT_V(8); PG8_WAIT_L(0); PG8_BAR; PG8_MMA(1, 0, At, B0); PG8_MMA(1, 1, At, B1); PG8_BAR; PG8_SCHED;
            } else {
            PG8_LDB(B0, 0, 0); PG8_SCHED; PG8_LDA(At, 0, 0); PG8_STAGE(PG8_SA(1, 1), a1 + hstep, voffA);
            PG8_WAIT_L(8); PG8_BAR; PG8_WAIT_L(0); PG8_MMA(0, 0, At, B0); PG8_BAR; PG8_SCHED;
            PG8_LDB(B1, 0, 1); PG8_STAGE(PG8_SB(0, 0), b2, voffB);
            PG8_BAR; PG8_WAIT_L(0); PG8_MMA(0, 1, At, B1); PG8_BAR;
            PG8_LDA(At, 0, 1); PG8_STAGE(PG8_SA(0, 0), a2, voffA);
            PG8_BAR; PG8_WAIT_L(0); PG8_MMA(1, 0, At, B0); PG8_BAR; PG8_SCHED;
            PG8_STAGE(PG8_SB(0, 1), b2 + hstep, voffB);
            PG8_WAIT_V(6); PG8_BAR; PG8_MMA(1, 1, At, B1); PG8_BAR;
            PG8_LDB(B0, 1, 0); PG8_SCHED; PG8_LDA(At, 1, 0); PG8_STAGE(PG8_SA(0, 1), a2 + hstep, voffA);
            PG8_WAIT_L(8); PG8_BAR; PG8_WAIT_L(0); PG8_MMA(0, 0, At, B0); PG8_BAR; PG8_SCHED;
            PG8_LDB(B1, 1, 1); PG8_STAGE(PG8_SB(1, 0), b3, voffB);
            PG8_BAR; PG8_WAIT_L(0); PG8_MMA(0, 1, At, B1); PG8_BAR;
            PG8_LDA(At, 1, 1); PG8_STAGE(PG8_SA(1, 0), a3, voffA);
            PG8_BAR; PG8_WAIT_L(0); PG8_MMA(1, 0, At, B0); PG8_BAR; PG8_SCHED;
            PG8_STAGE(PG8_SB(1, 1), b3 + hstep, voffB);
            PG8_WAIT_V(6); PG8_BAR; PG8_MMA(1, 1, At, B1); PG8_BAR;
            }
        }
        if constexpr (ALIGN_EPI) { if (wr == 0) PG8_BAR; }
        if constexpr (!Epi::AFTER_DRAIN) { E(acc, cur, wr, wc, fr, fq); S.done(cur); }
        if (!has_next) break;
#pragma unroll
        for (int a = 0; a < 2; ++a)
#pragma unroll
            for (int b = 0; b < 2; ++b)
#pragma unroll
                for (int m = 0; m < 4; ++m)
#pragma unroll
                    for (int n = 0; n < 2; ++n) acc[a][b][m][n] = (f32x4){0.f, 0.f, 0.f, 0.f};
        cur = nxt; cA = nA; cB = nB; ++ui;
        if constexpr (ALIGN_EPI) { if (wr == 1) PG8_BAR; }
    }
    PG8_WAIT_V(0);
    if constexpr (!ALIGN_EPI) { if (wr == 0) PG8_BAR; }
    PG8_BAR;
    if constexpr (Epi::AFTER_DRAIN) { E.fused(acc, cur, wr, wc, fr, fq, lds, wid, lane); S.done(cur); }
#undef PG8_SA
#undef PG8_SB
#undef PG8_STAGE
#undef PG8_LDA
#undef PG8_LDB
#undef PG8_MMA
#undef PG8_WAIT_V
#undef PG8_WAIT_L
#undef PG8_BAR
#undef PG8_SCHED
}
}
template <class CM>
__device__ __forceinline__ void tr_item(const float* W, int ldw, const float* gain, bf16_t* out, int K, int R0, int k0, const CM& cm, LAS float* scr, int lane) {
    const int col = cm(R0 + (lane & 31));
    {
        float vv[32];
        const float* wp = W + (size_t)(k0 + (lane >> 5)) * ldw + (col >= 0 ? col : 0); const size_t wstep = (size_t)2 * ldw;
#pragma unroll
        for (int i = 0; i < 32; ++i) { vv[i] = *wp; wp += wstep; }
        if (col < 0) {
#pragma unroll
            for (int i = 0; i < 32; ++i) vv[i] = 0.f;
        }
#pragma unroll
        for (int i = 0; i < 32; ++i) { const int kk = 2 * i + (lane >> 5); float v = vv[i]; if (gain) v *= gain[k0 + kk]; scr[kk * 33 + (lane & 31)] = v; }
    }
    asm volatile("s_waitcnt lgkmcnt(0)" ::: "memory");
    const int ch = lane & 7;
#pragma unroll
    for (int j = 0; j < 4; ++j) {
        const int n = (lane >> 3) + 8 * j; const LAS float* s = scr + (8 * ch) * 33 + n;
        u32x4 o; o.x = cvt_pk_bf16(s[0], s[33]); o.y = cvt_pk_bf16(s[66], s[99]); o.z = cvt_pk_bf16(s[132], s[165]); o.w = cvt_pk_bf16(s[198], s[231]);
        *(u32x4*)(out + (size_t)(R0 + n) * K + k0 + 8 * ch) = o;
    }
    asm volatile("s_waitcnt lgkmcnt(0)" ::: "memory");
}
__device__ __forceinline__ int rperm16(int d) { return d < 16 ? ((d & 1) ? (d >> 1) + 8 : (d >> 1)) : d; }
__device__ __forceinline__ int rperm8(int d) { return d < 8 ? ((d & 1) ? (d >> 1) + 4 : (d >> 1)) : d; }
struct CmW1 {
    __device__ __forceinline__ int operator()(int cidx) const {
        const int tt = cidx >> 8, o = cidx & 255;
        switch (tt) {
            case 0: return o;
            case 1: return 256 + o;
            case 2: return 512 + o;
            case 3: return 772 + (o & ~63) + rperm16(o & 63);
            case 4: return 1156 + (o & ~31) + rperm8(o & 31);
            case 5: return 1452 + (o & ~31) + rperm8(o & 31);
            case 6: return 1708 + (o & ~31) + rperm8(o & 31);
            case 7: return 1964 + o;
            case 8: return 2220 + o;
            default:
                if (o < 64) return 1028 + rperm16(o);
                if (o < 128) return 1092 + (o - 64);
                if (o < 160) return 1412 + rperm8(o - 128);
                if (o < 164) return 768 + (o - 160);
                if (o < 172) return 1444 + (o - 164);
                return -1;
        }
    }
};
struct CmId { __device__ __forceinline__ int operator()(int r) const { return r; } };
struct CmG { __device__ __forceinline__ int operator()(int r) const { const int br = 2 * ((r >> 7) & 1) + ((r >> 4) & 1), d = 64 * (r >> 8) + 16 * ((r >> 5) & 3) + (r & 15); return br * DM + d; } };
struct CmF1 { __device__ __forceinline__ int operator()(int r) const { const int j = ((r >> 8) << 7) + (r & 127); return ((r >> 7) & 1) ? FF + j : j; } };

__device__ __forceinline__ void prep_mixer(const Ctx& c0, int l) {
    PHASE_CTX(c0);
    __syncthreads();
    LAS float* scr = (LAS float*)(c.lds + c.wid * 8448);
    const int gw = c.blk * 8 + c.wid, NGW = c.nblk * 8;
    constexpr int I1 = 16 * 80, IG = 16 * 128, IB = 4 * 4 * 32, IO = 16 * 32;
    constexpr int NIT = I1 + IG + IB + IO;
    for (int it = gw; it < NIT; it += NGW) {
        int r = it;
        if (r < I1) { tr_item(c.w_in + (size_t)l * DM * INC, INC, c.norm_mix_g + l * DM, WSP(bf16_t, OFF_W1T), DM, (r % 80) * 32, (r / 80) * 64, CmW1(), scr, c.lane); continue; } r -= I1;
        if (r < IG) { tr_item(c.w_gate + (size_t)l * DM * 4096, 4096, c.norm_mix_g + l * DM, WSP(bf16_t, OFF_WGT), DM, (r % 128) * 32, (r / 128) * 64, CmG(), scr, c.lane); continue; } r -= IG;
        if (r < IB) { const int n = r / 128, q = r % 128; tr_item(c.w_branch + ((size_t)l * 4 + n) * 256 * DM, DM, nullptr, WSP(bf16_t, OFF_WBT) + (size_t)n * DM * 256, 256, (q % 32) * 32, (q / 32) * 64, CmId(), scr, c.lane); continue; } r -= IB;
        tr_item(c.w_out + (size_t)l * DM * DM, DM, nullptr, WSP(bf16_t, OFF_WOT), DM, (r % 32) * 32, (r / 32) * 64, CmId(), scr, c.lane);
    }
    __syncthreads();
}
__device__ __forceinline__ void prep_ffn(const Ctx& c0, int l) {
    PHASE_CTX(c0);
    __syncthreads();
    LAS float* scr = (LAS float*)(c.lds + c.wid * 8448);
    const int gw = c.blk * 8 + c.wid, NGW = c.nblk * 8;
    constexpr int IF1 = 16 * 176, IF2 = 44 * 32;
    for (int it = gw; it < IF1 + IF2; it += NGW) {
        int r = it;
        if (r < IF1) { tr_item(c.w_ffn_in + (size_t)l * DM * 2 * FF, 2 * FF, c.norm_ffn_g + l * DM, WSP(bf16_t, OFF_WF1T), DM, (r % 176) * 32, (r / 176) * 64, CmF1(), scr, c.lane); continue; } r -= IF1;
        tr_item(c.w_ffn_out + (size_t)l * FF * DM, DM, nullptr, WSP(bf16_t, OFF_WF2T), FF, (r % 32) * 32, (r / 32) * 64, CmId(), scr, c.lane);
    }
    __syncthreads();
}

__device__ __forceinline__ void norm_row2(const float* xrow0, const float* xrow1, bf16_t* brow0, bf16_t* brow1, float* rs_out0, float* rs_out1, int lane) {
    const f32x4* xr0 = (const f32x4*)xrow0 + 2 * lane; const f32x4* xr1 = (const f32x4*)xrow1 + 2 * lane;
    f32x4 v[2][4]; float s0 = 0.f, s1 = 0.f;
#pragma unroll
    for (int j = 0; j < 2; ++j) { v[0][2 * j] = xr0[128 * j]; v[0][2 * j + 1] = xr0[128 * j + 1]; v[1][2 * j] = xr1[128 * j]; v[1][2 * j + 1] = xr1[128 * j + 1]; }
#pragma unroll
    for (int j = 0; j < 4; ++j) { s0 += (v[0][j].x * v[0][j].x + v[0][j].y * v[0][j].y) + (v[0][j].z * v[0][j].z + v[0][j].w * v[0][j].w);
                                  s1 += (v[1][j].x * v[1][j].x + v[1][j].y * v[1][j].y) + (v[1][j].z * v[1][j].z + v[1][j].w * v[1][j].w); }
    s0 = wave_sum(s0); s1 = wave_sum(s1);
    if (lane < 16) { rs_out0[lane] = (lane == 0) ? s0 : 0.f; rs_out1[lane] = (lane == 0) ? s1 : 0.f; }
#pragma unroll
    for (int r = 0; r < 2; ++r) { u32x4* o16 = (u32x4*)(r ? brow1 : brow0) + lane;
#pragma unroll
        for (int j = 0; j < 2; ++j) { u32x4 w; w.x = cvt_pk_bf16(v[r][2 * j].x, v[r][2 * j].y); w.y = cvt_pk_bf16(v[r][2 * j].z, v[r][2 * j].w); w.z = cvt_pk_bf16(v[r][2 * j + 1].x, v[r][2 * j + 1].y); w.w = cvt_pk_bf16(v[r][2 * j + 1].z, v[r][2 * j + 1].w); o16[64 * j] = w; } }
}
__device__ __forceinline__ void norm_pass(const Ctx& c0, const float* X) {
    PHASE_CTX(c0);
    const int gw = c.blk * 8 + c.wid, NGW = c.nblk * 8;
    for (int m = 2 * gw; m < T; m += 2 * NGW)
        norm_row2(X + (size_t)m * DM, X + (size_t)(m + 1) * DM, WSP(bf16_t, OFF_XB) + (size_t)m * DM, WSP(bf16_t, OFF_XB) + (size_t)(m + 1) * DM, WSP(float, OFF_SS) + (size_t)m * 16, WSP(float, OFF_SS) + (size_t)(m + 1) * 16, c.lane);
}
__device__ __forceinline__ float rs_of(float ss) { return __builtin_amdgcn_rsqf(ss * (1.0f / DM) + EPS); }
__device__ __forceinline__ float rs_row(const float* ssp, size_t tok) {
    const f32x4* q = (const f32x4*)(ssp + tok * 16); const f32x4 a = q[0], b = q[1], c2 = q[2], d = q[3];
    return rs_of((((a.x + a.y) + (a.z + a.w)) + ((b.x + b.y) + (b.z + b.w))) + (((c2.x + c2.y) + (c2.z + c2.w)) + ((d.x + d.y) + (d.z + d.w))));
}
__device__ __forceinline__ size_t ss_off(int idx) { return (size_t)(idx & 1) * T * 16; }
__device__ __forceinline__ float rs_row_coop(const float* ssp, size_t tok, int fq) {
    const f32x4 a = *(const f32x4*)(ssp + tok * 16 + 4 * fq);
    float s = (a.x + a.y) + (a.z + a.w);
    { const auto r_ = __builtin_amdgcn_permlane16_swap(__float_as_uint(s), __float_as_uint(s), false, false); s = __uint_as_float(r_[0]) + __uint_as_float(r_[1]); }
    { const auto r_ = __builtin_amdgcn_permlane32_swap(__float_as_uint(s), __float_as_uint(s), false, false); s = __uint_as_float(r_[0]) + __uint_as_float(r_[1]); }
    return rs_of(s);
}
__device__ __forceinline__ void final_norm(const Ctx& c0) {
    PHASE_CTX(c0);
    const int gw = c.blk * 8 + c.wid, NGW = c.nblk * 8;
    const float* X = WSP(float, OFF_X);
    for (int m = 2 * gw; m < T; m += 2 * NGW) {
        const f32x4* xr = (const f32x4*)(X + (size_t)m * DM) + c.lane;
        const float rs0 = rs_row(WSP(float, OFF_SS) + ss_off(8), m), rs1 = rs_row(WSP(float, OFF_SS) + ss_off(8), m + 1);
        f32x4* o = (f32x4*)(c.out + (size_t)m * DM) + c.lane; const f32x4* g = (const f32x4*)c.final_norm_g + c.lane;
        f32x4 v[8];
#pragma unroll
        for (int j = 0; j < 8; ++j) v[j] = xr[64 * j];
#pragma unroll
        for (int j = 0; j < 8; ++j) o[64 * j] = v[j] * (j < 4 ? rs0 : rs1) * g[64 * (j & 3)];
    }
}

__device__ __forceinline__ void prologue(const Ctx& c0) {
    PHASE_CTX(c0);
    prep_mixer(c, 0); prep_ffn(c, 0);
    const int gw = c.blk * 8 + c.wid, NGW = c.nblk * 8;
    {
        LAS float* scr = (LAS float*)(c.lds + c.wid * 8448);
        for (int it = gw; it < 4 * 16 * 16; it += NGW) { const int l = it >> 8, r = it & 255;
            tr_item(c.w_mem_kv + (size_t)l * DM * 512, 512, c.norm_mem_g + l * DM, WSP(bf16_t, OFF_WMEMT) + (size_t)l * 512 * DM, DM, (r % 16) * 32, (r / 16) * 64, CmId(), scr, c.lane); }
    }
    for (int m = 2 * gw; m < NB * MEML; m += 2 * NGW) norm_row2(c.mem + (size_t)m * DM, c.mem + (size_t)(m + 1) * DM, WSP(bf16_t, OFF_MEMB) + (size_t)m * DM, WSP(bf16_t, OFF_MEMB) + (size_t)(m + 1) * DM, WSP(float, OFF_MISC) + (size_t)m * 16, WSP(float, OFF_MISC) + (size_t)(m + 1) * 16, c.lane);
    for (int i = c.blk * NTHREADS + c.tid; i < T * 12; i += c.nblk * NTHREADS) {
        const int tok = i / 12, k = i % 12;
        const float p = (float)c.pos[tok];
        if (k < 8) { const float invf = (float)pow(500000.0, -(double)((float)(2 * k) / 16.0f)); const float ang = p * invf; float* o = WSP(float, OFF_CS16) + (size_t)tok * 16 + 2 * k; o[0] = (float)cos((double)ang); o[1] = (float)sin((double)ang); }
        else { const int kk = k - 8; const float invf = (float)pow(500000.0, -(double)((float)(2 * kk) / 8.0f)); const float ang = p * invf; float* o = WSP(float, OFF_CS8) + (size_t)tok * 8 + 2 * kk; o[0] = (float)cos((double)ang); o[1] = (float)sin((double)ang); }
    }
    if (c.blk == 0 && c.tid < DEPTH) {
        const int l = c.tid; const float* lv = c.diff_lambda + l * 128;
        float s1 = 0.f, s2 = 0.f;
        for (int i = 0; i < 32; ++i) { s1 += lv[i] * lv[32 + i]; s2 += lv[64 + i] * lv[96 + i]; }
        const float li = 0.8f - 0.6f * expf(-0.3f * (float)l);
        float* o = WSP(float, OFF_MISC) + 65536 + 2 * l; o[0] = expf(s1) - expf(s2) + li; o[1] = 1.0f - li;
    }
    norm_pass(c, c.x);
}

__device__ __forceinline__ void rope2(f32x4& v, const float* cs) {
    const f32x4 t = *(const f32x4*)cs;
    const float a0 = v.x, b0 = v.y, a1 = v.z, b1 = v.w;
    v.x = a0 * t.x - b0 * t.y; v.y = b0 * t.x + a0 * t.y; v.z = a1 * t.z - b1 * t.w; v.w = b1 * t.z + a1 * t.w;
}
__device__ __forceinline__ void rope2v(f32x4& v, const f32x4 t) {
    const float a0 = v.x, b0 = v.y, a1 = v.z, b1 = v.w;
    v.x = a0 * t.x - b0 * t.y; v.y = b0 * t.x + a0 * t.y; v.z = a1 * t.z - b1 * t.w; v.w = b1 * t.z + a1 * t.w;
}
template <int TT>
__device__ __forceinline__ void z_group(unsigned char* ws, const float* b_forget, int l, size_t tok, int c0, f32x4 v, const f32x4 tab, u32x2* outw = nullptr) {
    const float QS = 0.125f * LOG2E, QS32 = 0.17677669529663687f * LOG2E;
    bool store = true;
    if (TT == 0 || TT == 8) v = v * QS;
    else if (TT == 3) { const int d = c0 & 63; if (d < 16) rope2v(v, tab); v = v * QS; }
    else if (TT == 4 || TT == 6) { const int d = c0 & 31; if (d < 8) rope2v(v, tab); }
    else if (TT == 5) { const int d = c0 & 31; if (d < 8) rope2v(v, tab); v = v * QS32; }
    else if (TT == 9) { const int cc = c0 - 2304;
        const float* cs16 = (const float*)(ws + OFF_CS16) + tok * 16; const float* cs8 = (const float*)(ws + OFF_CS8) + tok * 8;
        if (cc < 64) { if (cc < 16) rope2(v, cs16 + cc); }
        else if (cc < 128) {}
        else if (cc < 160) { const int d = cc - 128; if (d < 8) rope2(v, cs8 + d); }
        else if (cc < 164) { f32x4 o;
#pragma unroll
            for (int i = 0; i < 4; ++i) { const float xx = v[i] + b_forget[l * 4 + i]; o[i] = (fminf(xx, 0.f) - log1pf(expf(-fabsf(xx)))) * LOG2E; }
            *(f32x4*)((float*)(ws + OFF_FL) + tok * 4) = o; store = false; }
        else if (cc < 172) { *(f32x4*)((float*)(ws + OFF_WI) + tok * 8 + (cc - 164)) = v * 0.0625f; store = false; }
        else store = false;
    }
    if (store) { u32x2 w; w.x = cvt_pk_bf16(v.x, v.y); w.y = cvt_pk_bf16(v.z, v.w); if (outw) *outw = w; else *(u32x2*)((bf16_t*)(ws + OFF_Z) + tok * ZP + c0) = w; }
}
struct EpiZ {
    static constexpr bool PERM = false, AFTER_DRAIN = false;
    unsigned char* ws; const float* b_forget; const float* ss; int l;
    template <int TT> __device__ __forceinline__ void run(const f32x4 (&acc)[2][2][4][2], const pg8::Unit& u, int wr, int wc, int fr, int fq) const {
        constexpr bool ROPE = (TT == 3 || TT == 4 || TT == 5 || TT == 6);
        float rs8[2][4]; f32x4 tab[2][4][2];
#pragma unroll
        for (int ai = 0; ai < 2; ++ai)
#pragma unroll
            for (int m = 0; m < 4; ++m) {
                const size_t tok = (size_t)u.pm * 256 + ai * 128 + wr * 64 + m * 16 + fr;
                rs8[ai][m] = rs_row_coop(ss, tok, fq);
#pragma unroll
                for (int bj = 0; bj < 2; ++bj) {
                    tab[ai][m][bj] = (f32x4){1.f, 0.f, 1.f, 0.f};
                    if (ROPE) { const int c0 = u.pn * 256 + bj * 128 + wc * 32 + 4 * fq;
                        const int d = (TT == 3) ? (c0 & 63) : (c0 & 31); const int dd = d < ((TT == 3) ? 16 : 8) ? d : 0;
                        tab[ai][m][bj] = *(const f32x4*)((TT == 3) ? ((const float*)(ws + OFF_CS16) + tok * 16 + dd) : ((const float*)(ws + OFF_CS8) + tok * 8 + dd)); }
                }
            }
#pragma unroll
        for (int ai = 0; ai < 2; ++ai)
#pragma unroll
            for (int m = 0; m < 4; ++m) {
                const size_t tok = (size_t)u.pm * 256 + ai * 128 + wr * 64 + m * 16 + fr;
#pragma unroll
                for (int bj = 0; bj < 2; ++bj) {
                    if (TT == 9) {
#pragma unroll
                        for (int n = 0; n < 2; ++n) z_group<TT>(ws, b_forget, l, tok, u.pn * 256 + bj * 128 + wc * 32 + n * 16 + 4 * fq, acc[ai][bj][m][n] * rs8[ai][m], tab[ai][m][bj]);
                    } else {
                        u32x2 w0, w1;
                        z_group<TT>(ws, b_forget, l, tok, u.pn * 256 + bj * 128 + wc * 32 + 4 * fq, acc[ai][bj][m][0] * rs8[ai][m], tab[ai][m][bj], &w0);
                        z_group<TT>(ws, b_forget, l, tok, u.pn * 256 + bj * 128 + wc * 32 + 16 + 4 * fq, acc[ai][bj][m][1] * rs8[ai][m], tab[ai][m][bj], &w1);
                        asm volatile("s_nop 1" : "+v"(w0.x), "+v"(w0.y), "+v"(w1.x), "+v"(w1.y));
                        const auto s0 = __builtin_amdgcn_permlane16_swap(w0.x, w1.x, false, false);
                        const auto s1 = __builtin_amdgcn_permlane16_swap(w0.y, w1.y, false, false);
                        u32x4 w; w.x = s0[0]; w.y = s1[0]; w.z = s0[1]; w.w = s1[1];
                        st16_wt((bf16_t*)(ws + OFF_Z) + tok * ZP + u.pn * 256 + bj * 128 + wc * 32 + ((fq & 1) ? 16 + 4 * (fq - 1) : 4 * fq), w);
                    }
                }
            }
    }
    __device__ __forceinline__ void operator()(const f32x4 (&acc)[2][2][4][2], const pg8::Unit& u, int wr, int wc, int fr, int fq) const {
        { int ln_; asm volatile("v_mbcnt_lo_u32_b32 %0, -1, 0\n\tv_mbcnt_hi_u32_b32 %0, -1, %0" : "=v"(ln_)); fr = ln_ & 15; fq = ln_ >> 4; }
        switch (u.pn) {
            case 0: case 8: run<0>(acc, u, wr, wc, fr, fq); break;
            case 3: run<3>(acc, u, wr, wc, fr, fq); break;
            case 4: case 6: run<4>(acc, u, wr, wc, fr, fq); break;
            case 5: run<5>(acc, u, wr, wc, fr, fq); break;
            case 9: run<9>(acc, u, wr, wc, fr, fq); break;
            default: run<1>(acc, u, wr, wc, fr, fq); break;
        }
    }
};
__device__ __forceinline__ void p1_units(const Ctx& c0, int l) {
    PHASE_CTX(c0);
    {
        pg8::Gemm g{WSP(bf16_t, OFF_XB), WSP(bf16_t, OFF_W1T), T, ZP, DM}; pg8::StaticOrder S; S.init(T, ZP, c.nblk, c.blk);
        EpiZ E{c.ws, c.b_forget, WSP(float, OFF_SS) + ss_off(2 * l), l};
        pg8::gemm_phase<EpiZ, pg8::StaticOrder, true, true>(c.lds, g, S, E, c.tid);
    }
    if (l == 0) {
        const int fr = c.lane & 15, fq = c.lane >> 4, wr = c.wid >> 2, wc = c.wid & 3;
        __syncthreads();
        for (int u = c.blk; u < 256; u += c.nblk) {
            f32x4 acc[4][2]; acc_zero(acc);
            const int lyr = u >> 6, pm = (u >> 2) & 15, pn = u & 3;
            gemm_tile(acc, WSP(bf16_t, OFF_MEMB) + (size_t)pm * 128 * DM, DM, WSP(bf16_t, OFF_WMEMT) + ((size_t)lyr * 512 + pn * 128) * DM, DM, DM, c.lds, c.tid);
#pragma unroll
            for (int m = 0; m < 4; ++m) {
                const int row = pm * 128 + wr * 64 + m * 16 + fr; const float rs = rs_of(WSP(float, OFF_MISC)[(size_t)row * 16]);
#pragma unroll
                for (int n = 0; n < 2; ++n) { const int c0 = pn * 128 + wc * 32 + n * 16 + 4 * fq; const f32x4 v = acc[m][n] * rs;
                    u32x2 w; w.x = cvt_pk_bf16(v.x, v.y); w.y = cvt_pk_bf16(v.z, v.w); *(u32x2*)(WSP(bf16_t, OFF_MEMKV) + ((size_t)lyr * 2048 + row) * 512 + c0) = w; }
            }
        }
    }
}

__device__ __forceinline__ void scan_unit(const Ctx& c, int bh) {
    const int b = bh >> 2, h = bh & 3;
    const float* fl = WSP(float, OFF_FL) + (size_t)b * SEQ * 4 + h; float* cum = WSP(float, OFF_CUM) + (size_t)bh * SEQ;
    LAS float* wt = (LAS float*)(c.lds);
    float v[8]; float run = 0.f;
#pragma unroll
    for (int i = 0; i < 8; ++i) { run += fl[(size_t)(c.tid * 8 + i) * 4]; v[i] = run; }
    float inc = run;
#pragma unroll
    for (int o = 1; o < 64; o <<= 1) { const float t = __shfl_up(inc, o); if (c.lane >= o) inc += t; }
    if (c.lane == 63) wt[c.wid] = inc;
    __syncthreads();
    float base = inc - run;
    for (int w = 0; w < c.wid; ++w) base += wt[w];
#pragma unroll
    for (int i = 0; i < 8; ++i) cum[c.tid * 8 + i] = base + v[i];
    __syncthreads();
}

__device__ __forceinline__ void indexer_unit(const Ctx& c, int b, int g) {
    int lane = c.lane; asm volatile("" : "+v"(lane));
    const int wid = c.wid, q = lane & 15, kq = lane >> 4;
    const int t = 16 * g + q; const size_t tok = (size_t)b * SEQ + t;
    const bf16_t* Z = WSP(bf16_t, OFF_Z);
    volatile LAS unsigned* cb = (volatile LAS unsigned*)(c.lds);
    bf16x8 qf[8]; float w[8];
#pragma unroll
    for (int hh = 0; hh < 8; ++hh) { qf[hh] = *(const bf16x8*)(Z + tok * ZP + 1024 + hh * 32 + 8 * kq); w[hh] = WSP(float, OFF_WI)[tok * 8 + hh]; }
    const int npairs = (g + 2) >> 1;
    const int nwpairs = 2 * (g >> 2) + 2;
    const int njj = (npairs - wid + 7) >> 3;
    unsigned key[16][8];
    const bf16_t* Zk = Z + (size_t)b * SEQ * ZP + 2432 + 8 * kq;
    const int krmax = 16 * g + 15;
    bf16x8 pf[2][2];
#define KI_LOAD(JJ) do { _Pragma("unroll") for (int tl_ = 0; tl_ < 2; ++tl_) { int kr_ = 32 * (wid + 8 * (JJ)) + 16 * tl_ + q; kr_ = kr_ < krmax ? kr_ : krmax; \
        pf[(JJ) % 2][tl_] = *(const bf16x8*)(Zk + (size_t)kr_ * ZP); } } while (0)
    if (0 < njj) KI_LOAD(0);
#pragma unroll
    for (int jj = 0; jj < 16; ++jj) {
#pragma unroll
        for (int e = 0; e < 8; ++e) key[jj][e] = 0u;
        if (jj < njj) {
            if (jj + 1 < njj) KI_LOAD(jj + 1);
            const int pp = wid + 8 * jj;
#pragma unroll
            for (int tl = 0; tl < 2; ++tl) {
                const int kbase = 32 * pp + 16 * tl;
                if (kbase <= 16 * g) {
                    const bf16x8 af = pf[jj % 2][tl];
                    f32x4 sc = (f32x4){0.f, 0.f, 0.f, 0.f};
                    f32x4 d[8];
#pragma unroll
                    for (int hh = 0; hh < 8; ++hh) d[hh] = __builtin_amdgcn_mfma_f32_16x16x32_bf16(af, qf[hh], (f32x4){0.f, 0.f, 0.f, 0.f}, 0, 0, 0);
#pragma unroll
                    for (int hh = 0; hh < 8; ++hh)
#pragma unroll
                        for (int i = 0; i < 4; ++i) { const int db_ = __float_as_int(d[hh][i]); sc[i] += w[hh] * __int_as_float(db_ > 0 ? db_ : 0); }
#pragma unroll
                    for (int i = 0; i < 4; ++i) { const unsigned bits = __float_as_uint(sc[i]); key[jj][tl * 4 + i] = bits ^ (((unsigned)((int)bits >> 31)) | 0x80000000u); }
                    if (kbase == 16 * g) {
#pragma unroll
                        for (int i = 0; i < 4; ++i) if (kbase + 4 * kq + i > t) key[jj][tl * 4 + i] = 0u;
                    }
                }
            }
            asm volatile("" ::: "memory");
        }
    }
#undef KI_LOAD
    int par = 0;
    unsigned tau = 1u;
    if (g >= 16) {
        volatile LAS unsigned* tf = cb + 512;
        const unsigned nel = 8u * (unsigned)(njj > 0 ? njj : 0);
#define IDX_COUNT_GE(CAND, TOT) do { const unsigned cd_ = (CAND), cm_ = cd_ - 1u; unsigned a0_ = 0u, a1_ = 0u; \
            _Pragma("unroll") for (int jj = 0; jj < 16; ++jj) if (jj < njj) { _Pragma("unroll") for (int e = 0; e < 8; e += 4) { unsigned m0_, m1_, m2_, m3_; \
                asm("v_med3_u32 %0, %1, %2, %3" : "=v"(m0_) : "v"(key[jj][e]), "v"(cm_), "v"(cd_)); asm("v_med3_u32 %0, %1, %2, %3" : "=v"(m1_) : "v"(key[jj][e + 1]), "v"(cm_), "v"(cd_)); \
                asm("v_med3_u32 %0, %1, %2, %3" : "=v"(m2_) : "v"(key[jj][e + 2]), "v"(cm_), "v"(cd_)); asm("v_med3_u32 %0, %1, %2, %3" : "=v"(m3_) : "v"(key[jj][e + 3]), "v"(cm_), "v"(cd_)); \
                a0_ = a0_ + m0_ + m1_; a1_ = a1_ + m2_ + m3_; } } \
            unsigned c_ = (a0_ + a1_) - nel * cm_; \
            { const auto r_ = __builtin_amdgcn_permlane16_swap(c_, c_, false, false); c_ = r_[0] + r_[1]; } \
            { const auto r_ = __builtin_amdgcn_permlane32_swap(c_, c_, false, false); c_ = r_[0] + r_[1]; } \
            if (kq == 0) cb[par * 128 + q * 8 + wid] = c_; \
            __syncthreads(); \
            const u32x4 t0_ = *(const LAS u32x4*)((const LAS unsigned*)cb + par * 128 + q * 8), t1_ = *(const LAS u32x4*)((const LAS unsigned*)cb + par * 128 + q * 8 + 4); \
            par ^= 1; TOT = ((t0_.x + t0_.y) + (t0_.z + t0_.w)) + ((t1_.x + t1_.y) + (t1_.z + t1_.w)); } while (0)
        unsigned kmax, kmin;
        { unsigned m_ = 0u, n_ = 0xFFFFFFFFu;
#pragma unroll
          for (int jj = 0; jj < 16; ++jj) if (jj < njj) {
#pragma unroll
              for (int e = 0; e < 8; ++e) { const unsigned kv_ = key[jj][e], kd_ = kv_ - 1u; m_ = m_ > kv_ ? m_ : kv_; n_ = n_ < kd_ ? n_ : kd_; } }
          { const auto r_ = __builtin_amdgcn_permlane16_swap(m_, m_, false, false); m_ = r_[0] > r_[1] ? r_[0] : r_[1]; }
          { const auto r_ = __builtin_amdgcn_permlane32_swap(m_, m_, false, false); m_ = r_[0] > r_[1] ? r_[0] : r_[1]; }
          { const auto r_ = __builtin_amdgcn_permlane16_swap(n_, n_, false, false); n_ = r_[0] < r_[1] ? r_[0] : r_[1]; }
          { const auto r_ = __builtin_amdgcn_permlane32_swap(n_, n_, false, false); n_ = r_[0] < r_[1] ? r_[0] : r_[1]; }
          if (kq == 0) { cb[par * 128 + q * 8 + wid] = m_; cb[256 + par * 128 + q * 8 + wid] = n_; }
          __syncthreads();
          const u32x4 t0_ = *(const LAS u32x4*)((const LAS unsigned*)cb + par * 128 + q * 8), t1_ = *(const LAS u32x4*)((const LAS unsigned*)cb + par * 128 + q * 8 + 4);
          const u32x4 s0_ = *(const LAS u32x4*)((const LAS unsigned*)cb + 256 + par * 128 + q * 8), s1_ = *(const LAS u32x4*)((const LAS unsigned*)cb + 256 + par * 128 + q * 8 + 4);
          par ^= 1;
          unsigned a_ = t0_.x > t0_.y ? t0_.x : t0_.y, b_ = t0_.z > t0_.w ? t0_.z : t0_.w, c2_ = t1_.x > t1_.y ? t1_.x : t1_.y, d_ = t1_.z > t1_.w ? t1_.z : t1_.w;
          a_ = a_ > b_ ? a_ : b_; c2_ = c2_ > d_ ? c2_ : d_; kmax = a_ > c2_ ? a_ : c2_;
          a_ = s0_.x < s0_.y ? s0_.x : s0_.y; b_ = s0_.z < s0_.w ? s0_.z : s0_.w; c2_ = s1_.x < s1_.y ? s1_.x : s1_.y; d_ = s1_.z < s1_.w ? s1_.z : s1_.w;
          a_ = a_ < b_ ? a_ : b_; c2_ = c2_ < d_ ? c2_ : d_; kmin = (a_ < c2_ ? a_ : c2_) + 1u; }
#define IDX_MAX_XAD(S, D, OUT) do { const unsigned s_ = (S), d_ = (D); unsigned m_ = 0u; \
            _Pragma("unroll") for (int jj = 0; jj < 16; ++jj) if (jj < njj) { _Pragma("unroll") for (int e = 0; e < 8; e += 2) { \
                const unsigned x0_ = (key[jj][e] ^ s_) + d_, x1_ = (key[jj][e + 1] ^ s_) + d_; const unsigned y_ = x0_ > x1_ ? x0_ : x1_; m_ = m_ > y_ ? m_ : y_; } } \
            { const auto r_ = __builtin_amdgcn_permlane16_swap(m_, m_, false, false); m_ = r_[0] > r_[1] ? r_[0] : r_[1]; } \
            { const auto r_ = __builtin_amdgcn_permlane32_swap(m_, m_, false, false); m_ = r_[0] > r_[1] ? r_[0] : r_[1]; } \
            if (kq == 0) cb[par * 128 + q * 8 + wid] = m_; \
            __syncthreads(); \
            const u32x4 t0_ = *(const LAS u32x4*)((const LAS unsigned*)cb + par * 128 + q * 8), t1_ = *(const LAS u32x4*)((const LAS unsigned*)cb + par * 128 + q * 8 + 4); \
            par ^= 1; \
            unsigned a_ = t0_.x > t0_.y ? t0_.x : t0_.y, b_ = t0_.z > t0_.w ? t0_.z : t0_.w, c2_ = t1_.x > t1_.y ? t1_.x : t1_.y, e_ = t1_.z > t1_.w ? t1_.z : t1_.w; \
            a_ = a_ > b_ ? a_ : b_; c2_ = c2_ > e_ ? c2_ : e_; OUT = a_ > c2_ ? a_ : c2_; } while (0)
        const float nf = (float)(t + 1);
#define IDX_NQ(CNT, OUT) do { float c_ = (float)(CNT); c_ = c_ < 0.5f ? 0.5f : c_; c_ = c_ > nf - 0.5f ? nf - 0.5f : c_; \
            OUT = __builtin_amdgcn_logf(nf - c_) - __builtin_amdgcn_logf(c_); } while (0)
        unsigned klo, khi, clo, chi; bool done = false, exact = false;
        { unsigned kp1 = 0x80000001u; asm volatile("" : "+v"(kp1));
          unsigned cpos; IDX_COUNT_GE(kp1, cpos);
          if (cpos > 256u) { klo = kp1; clo = cpos; khi = kmax + 1u; chi = 0u; }
          else if (cpos == 256u) { klo = kp1; clo = cpos; khi = kmax + 1u; chi = 0u; done = true; exact = true; tau = kp1; }
          else { klo = kmin; clo = (unsigned)(t + 1); khi = kp1; chi = cpos; } }
        float tlo, thi, t256; IDX_NQ(clo, tlo); IDX_NQ(chi, thi); IDX_NQ(256u, t256);
        float flo = 1.f, fhi = 1.f; int side = 0; unsigned forced = 0u;
#pragma unroll 1
        for (int it = 0; it < 96; ++it) {
            const unsigned width = khi - klo;
            if (!done && width <= 1u) { done = true; tau = klo; }
            if (__all(done)) break;
            const bool exb = !done && forced == 0u && clo == 257u;
            const bool exa = !done && forced == 0u && !exb && chi == 255u;
            if (__all(done || exa || exb)) {
                unsigned mx; IDX_MAX_XAD(exb ? 0xFFFFFFFFu : 0u, exb ? klo : 0u - khi, mx);
                if (exb) { klo = klo - 1u - mx; forced = klo + 1u; }
                else if (exa) { khi = khi + mx + 1u; forced = khi - 1u; }
                continue;
            }
            unsigned cand = klo + (width >> 1);
            if (it < 24) {
                const float vlo = __uint_as_float((int)klo < 0 ? (klo & 0x7fffffffu) : ~klo), vhi = __uint_as_float((int)khi < 0 ? (khi & 0x7fffffffu) : ~khi);
                const float wa = (t256 - tlo) * flo, wb = (thi - t256) * fhi;
                const unsigned cb_ = __float_as_uint(vlo + (vhi - vlo) * (wa * __builtin_amdgcn_rcpf(wa + wb)));
                cand = cb_ ^ (((unsigned)((int)cb_ >> 31)) | 0x80000000u);
            }
            if (forced != 0u) { cand = forced; forced = 0u; }
            cand = cand <= klo ? klo + 1u : cand; cand = cand >= khi ? khi - 1u : cand;
            if (done) cand = klo;
            unsigned tot; IDX_COUNT_GE(cand, tot);
            if (!done) {
                if (tot == 256u) { done = true; exact = true; tau = cand; }
                else if (tot > 256u) { klo = cand; clo = tot; IDX_NQ(tot, tlo); flo = 1.f; fhi = (side == 1) ? fhi * 0.5f : 1.f; side = 1; }
                else { khi = cand; chi = tot; IDX_NQ(tot, thi); fhi = 1.f; flo = (side == 2) ? flo * 0.5f : 1.f; side = 2; }
            }
        }
#undef IDX_MAX_XAD
#undef IDX_NQ
        if (!done) tau = klo;
        unsigned need = 0u, neq = 0u;
        if (!exact) { need = 256u - chi; neq = clo - chi; }
        if (c.tid == 0) tf[0] = 0u;
        __syncthreads();
        if (neq > need) tf[0] = 1u;
        __syncthreads();
        if (tf[0] != 0u) {
            unsigned lb = 0x80000000u + 4095u - (unsigned)(32 * wid + 4 * kq);
            asm volatile("" : "+v"(lb));
#pragma unroll
            for (int jj = 0; jj < 16; ++jj) if (jj < njj) {
#pragma unroll
                for (int e = 0; e < 8; ++e) { const unsigned kv_ = key[jj][e];
                    key[jj][e] = (kv_ > tau) ? 0xFFFFFFFFu : (kv_ == tau ? (lb - (unsigned)(256 * jj + 16 * (e >> 2) + (e & 3))) : 0u); } }
            unsigned prefix = 0x80000000u;
#pragma unroll 1
            for (int bit = 11; bit >= 0; --bit) {
                const unsigned cand = prefix | (1u << bit);
                unsigned tot; IDX_COUNT_GE(cand, tot);
                if (tot >= 256u) prefix = cand;
            }
            tau = prefix;
        }
#undef IDX_COUNT_GE
        __syncthreads();
    }
    unsigned* maskrow = WSP(unsigned, OFF_MASK) + tok * 128;
#pragma unroll
    for (int jj = 0; jj < 16; ++jj) {
        const int pp = wid + 8 * jj;
        if (pp < nwpairs) {
            unsigned wbits = 0u;
#pragma unroll
            for (int e = 0; e < 8; ++e) wbits |= ((key[jj][e] >= tau) ? 1u : 0u) << (16 * (e >> 2) + 4 * kq + (e & 3));
            { const auto r_ = __builtin_amdgcn_permlane16_swap(wbits, wbits, false, false); wbits = r_[0] | r_[1]; }
            { const auto r_ = __builtin_amdgcn_permlane32_swap(wbits, wbits, false, false); wbits = r_[0] | r_[1]; }
            if (kq == 0) maskrow[pp] = wbits;
        }
    }
}
__device__ __forceinline__ void p2_units(const Ctx& c0, int l, int qo = 0) {
    PHASE_CTX(c0);
    for (int u = c.blk; u < 32; u += c.nblk) scan_unit(c, u);
    const int nstat = (2048 / c.nblk > 2) ? (2048 / c.nblk - 2) : 0;
#pragma unroll 1
    for (int it = 0;; ++it) {
        int v;
        if (it < nstat) v = it * c.nblk + c.blk; else v = nstat * c.nblk + q_next(c, 16 * l + qo);
        if (v >= 2048) break;
        indexer_unit(c, v & 7, 255 - (v >> 3));
    }
}

__device__ __forceinline__ int crow(int r, int hi) { return (r & 3) + 8 * (r >> 2) + 4 * hi; }
constexpr float SM_THR = 6.0f;
struct SoftState { float l; bool seen; f32x16 o[2]; f32x16 negm; };
__device__ __forceinline__ void soft_init(SoftState& s) { s.l = 0.f; s.seen = false; s.o[0] = (f32x16){}; s.o[1] = (f32x16){}; s.negm = (f32x16){}; }
constexpr float SM_GROW = 65536.0f;
template <bool PK>
__device__ __forceinline__ void soft_update(SoftState& st, f32x16 (&S)[2]) {
    if (__any(st.l > SM_GROW)) {
        const float lp = st.l + __shfl_xor(st.l, 32);
        const int ex = (lp > SM_GROW) ? (int)(__float_as_uint(lp) >> 23) - 127 : 0;
        const float alpha = __uint_as_float((unsigned)(127 - ex) << 23), fe = (float)ex;
#pragma unroll
        for (int p = 0; p < 2; ++p)
#pragma unroll
            for (int r = 0; r < 16; ++r) S[p][r] -= fe;
        st.l *= alpha;
#pragma unroll
        for (int d = 0; d < 2; ++d)
#pragma unroll
            for (int r = 0; r < 16; ++r) st.o[d][r] *= alpha;
        { const float nm = st.negm[0] - fe;
#pragma unroll
          for (int r = 0; r < 16; ++r) st.negm[r] = nm; }
    }
    if (__any(!st.seen)) {
        float mx = S[0][0];
#pragma unroll
        for (int r = 1; r < 16; ++r) mx = fmaxf(mx, S[0][r]);
#pragma unroll
        for (int r = 0; r < 16; ++r) mx = fmaxf(mx, S[1][r]);
        mx = fmaxf(mx, __shfl_xor(mx, 32));
        const bool valid = mx != -INFINITY, first = valid && !st.seen;
        if (__any(first)) {
            const float delta = first ? mx : 0.f;
#pragma unroll
            for (int p = 0; p < 2; ++p)
#pragma unroll
                for (int r = 0; r < 16; ++r) S[p][r] -= delta;
            { const float nm = st.negm[0] - delta;
#pragma unroll
              for (int r = 0; r < 16; ++r) st.negm[r] = nm; }
        }
        st.seen = st.seen || valid;
    }
    f32x2 rs2 = (f32x2){0.f, 0.f};
#pragma unroll
    for (int p = 0; p < 2; ++p)
#pragma unroll
        for (int r = 0; r < 16; r += 2) { const float e0 = fexp2(S[p][r]), e1 = fexp2(S[p][r + 1]); S[p][r] = e0; S[p][r + 1] = e1; rs2 += (f32x2){e0, e1}; }
    st.l += rs2.x + rs2.y;
}
__device__ __forceinline__ bf16x8 pack_p(const f32x16& S, int s) {
    u32x4 w; w.x = cvt_pk_bf16_c(S[8 * s + 0], S[8 * s + 1]); w.y = cvt_pk_bf16_c(S[8 * s + 2], S[8 * s + 3]); w.z = cvt_pk_bf16_c(S[8 * s + 4], S[8 * s + 5]); w.w = cvt_pk_bf16_c(S[8 * s + 6], S[8 * s + 7]);
    return __builtin_bit_cast(bf16x8, w);
}
__device__ __forceinline__ bf16x8 vfrag(const LAS unsigned char* vp) {
    const v4i16_t lo = __builtin_amdgcn_ds_read_tr16_b64_v4i16((LAS v4i16_t*)vp);
    const v4i16_t hi = __builtin_amdgcn_ds_read_tr16_b64_v4i16((LAS v4i16_t*)(vp + 512));
    return (bf16x8){lo[0], lo[1], lo[2], lo[3], hi[0], hi[1], hi[2], hi[3]};
}
__device__ __forceinline__ void glds16(const void* gsrc, unsigned lds_dst) { unsigned keep;
    asm volatile("s_mov_b32 %0, m0\n\ts_mov_b32 m0, %2\n\ts_nop 0\n\tglobal_load_lds_dwordx4 %1, off\n\ts_mov_b32 m0, %0" : "=&s"(keep) : "v"(gsrc), "s"(lds_dst) : "memory"); }
__device__ __forceinline__ void glds4(const void* gsrc, unsigned lds_dst) { unsigned keep;
    asm volatile("s_mov_b32 %0, m0\n\ts_mov_b32 m0, %2\n\ts_nop 0\n\tglobal_load_lds_dword %1, off\n\ts_mov_b32 m0, %0" : "=&s"(keep) : "v"(gsrc), "s"(lds_dst) : "memory"); }
constexpr int ATT_SLOT = 17408;
constexpr int ATT_NSLOT = 4;
#define ATT_WAIT_BAR(n) do { switch (n) { case 0: asm volatile("s_waitcnt vmcnt(0) lgkmcnt(0)\n\ts_barrier" ::: "memory"); break; case 2: asm volatile("s_waitcnt vmcnt(2) lgkmcnt(0)\n\ts_barrier" ::: "memory"); break; \
    case 3: asm volatile("s_waitcnt vmcnt(3) lgkmcnt(0)\n\ts_barrier" ::: "memory"); break; case 4: asm volatile("s_waitcnt vmcnt(4) lgkmcnt(0)\n\ts_barrier" ::: "memory"); break; \
    default: asm volatile("s_waitcnt vmcnt(6) lgkmcnt(0)\n\ts_barrier" ::: "memory"); break; } } while (0)

template <int MODE, int SLOT, int NQS>
__device__ __forceinline__ void att_tile(const LAS unsigned char* lds, int j, int mp, const bf16x8 (&qf)[NQS], SoftState& sa, int t0, int tq, int r32, int hi, int vb, int mq, float cq) {
    const LAS unsigned char* kb = lds + SLOT * ATT_SLOT; const LAS unsigned char* vbase = kb + 8192 + vb; const LAS unsigned char* xb = kb + 16384;
    f32x16 S[2]; S[0] = (f32x16){}; S[1] = (f32x16){};
    if (MODE == 0) {
        const float cmq = cq + sa.negm[0];
#pragma unroll
        for (int p = 0; p < 2; ++p)
#pragma unroll
            for (int gq = 0; gq < 4; ++gq) { const f32x4 ck = *(const LAS f32x4*)(xb + (32 * p + 8 * gq + 4 * hi) * 4);
#pragma unroll
                for (int i = 0; i < 4; ++i) S[p][4 * gq + i] = cmq - ck[i]; }
    }
    if (MODE == 1) {
        const unsigned nmb = __float_as_uint(sa.negm[0]);
#pragma unroll
        for (int p = 0; p < 2; ++p) { const unsigned wsh = *(const LAS unsigned*)(xb + mq * 16 + ((j & 1) * 2 + p) * 4) >> (4 * hi);
#pragma unroll
            for (int r = 0; r < 16; ++r) { const unsigned t_ = (unsigned)__builtin_amdgcn_sbfe((int)wsh, (r & 3) + 8 * (r >> 2), 1);
                            S[p][r] = __uint_as_float((nmb & t_) | (0xFF800000u & ~t_)); } }
    }
    {
        bf16x8 kf[NQS][2];
#pragma unroll
        for (int s = 0; s < NQS; ++s)
#pragma unroll
            for (int p = 0; p < 2; ++p) kf[s][p] = *(const LAS bf16x8*)(kb + sw_off(32 * p + r32, 2 * (NQS * mp + s) + hi));
#pragma unroll
        for (int s = 0; s < NQS; ++s)
#pragma unroll
            for (int p = 0; p < 2; ++p) S[p] = __builtin_amdgcn_mfma_f32_32x32x16_bf16(kf[s][p], qf[s], (s == 0 && MODE != 0 && MODE != 1) ? sa.negm : S[p], 0, 0, 0);
    }
    constexpr bool VPRE = (MODE != 3);
    bf16x8 vf[2][2][2];
    if (VPRE) {
#pragma unroll
        for (int p = 0; p < 2; ++p)
#pragma unroll
            for (int s = 0; s < 2; ++s)
#pragma unroll
                for (int db = 0; db < 2; ++db) vf[p][s][db] = vfrag(vbase + db * 4096 + p * 2048 + s * 1024);
    }
    if (MODE == 0 || MODE == 2) {
        if (64 * j + 63 > t0) {
#pragma unroll
            for (int p = 0; p < 2; ++p)
#pragma unroll
                for (int r = 0; r < 16; ++r) { const int kv = 64 * j + 32 * p + crow(r, hi); if (kv > tq) S[p][r] = -INFINITY; }
        }
    }
    soft_update<true>(sa, S);
#pragma unroll
    for (int p = 0; p < 2; ++p)
#pragma unroll
        for (int s = 0; s < 2; ++s) {
            const bf16x8 pa = pack_p(S[p], s);
#pragma unroll
            for (int db = 0; db < 2; ++db) { const bf16x8 vv = VPRE ? vf[p][s][db] : vfrag(vbase + db * 4096 + p * 2048 + s * 1024);
                sa.o[db] = __builtin_amdgcn_mfma_f32_32x32x16_bf16(vv, pa, sa.o[db], 0, 0, 0); }
        }
}

template <int SLOT>
__device__ __forceinline__ void att_tile2(const LAS unsigned char* lds, int j, const bf16x8 (&qf)[4], SoftState& sa, f32x16 (&oB)[2], float& lB, int t0, int tq, int r32, int hi, int vb) {
    const LAS unsigned char* kb = lds + SLOT * ATT_SLOT; const LAS unsigned char* vbase = kb + 8192 + vb;
    if (__any(sa.l > SM_GROW || lB > SM_GROW)) {
        const float lpa = sa.l + __shfl_xor(sa.l, 32), lpb = lB + __shfl_xor(lB, 32); const float lp = lpa > lpb ? lpa : lpb;
        const int ex = (lp > SM_GROW) ? (int)(__float_as_uint(lp) >> 23) - 127 : 0;
        const float alpha = __uint_as_float((unsigned)(127 - ex) << 23), fe = (float)ex;
        sa.l *= alpha; lB *= alpha;
#pragma unroll
        for (int d = 0; d < 2; ++d)
#pragma unroll
            for (int r = 0; r < 16; ++r) { sa.o[d][r] *= alpha; oB[d][r] *= alpha; }
        { const float nm = sa.negm[0] - fe;
#pragma unroll
          for (int r = 0; r < 16; ++r) sa.negm[r] = nm; }
    }
    const bool diag = 64 * j + 63 > t0;
    f32x16 SA[2], SB[2];
    {   bf16x8 kf[4][2];
#pragma unroll
        for (int s = 0; s < 4; ++s)
#pragma unroll
            for (int p = 0; p < 2; ++p) kf[s][p] = *(const LAS bf16x8*)(kb + sw_off(32 * p + r32, 2 * s + hi));
#pragma unroll
        for (int p = 0; p < 2; ++p) { SA[p] = __builtin_amdgcn_mfma_f32_32x32x16_bf16(kf[0][p], qf[0], sa.negm, 0, 0, 0); SA[p] = __builtin_amdgcn_mfma_f32_32x32x16_bf16(kf[1][p], qf[1], SA[p], 0, 0, 0);
                                      SB[p] = __builtin_amdgcn_mfma_f32_32x32x16_bf16(kf[2][p], qf[2], sa.negm, 0, 0, 0); SB[p] = __builtin_amdgcn_mfma_f32_32x32x16_bf16(kf[3][p], qf[3], SB[p], 0, 0, 0); }
    }
    if (diag) {
#pragma unroll
        for (int p = 0; p < 2; ++p)
#pragma unroll
            for (int r = 0; r < 16; ++r) { const int kv = 64 * j + 32 * p + crow(r, hi); if (kv > tq) { SA[p][r] = -INFINITY; SB[p][r] = -INFINITY; } }
    }
    if (__any(!sa.seen)) {
        float mx = SA[0][0];
#pragma unroll
        for (int r = 1; r < 16; ++r) mx = fmaxf(mx, SA[0][r]);
#pragma unroll
        for (int r = 0; r < 16; ++r) mx = fmaxf(mx, SA[1][r]);
        mx = fmaxf(mx, __shfl_xor(mx, 32));
        const bool valid = mx != -INFINITY, first = valid && !sa.seen;
        if (__any(first)) {
            const float delta = first ? mx : 0.f;
#pragma unroll
            for (int p = 0; p < 2; ++p)
#pragma unroll
                for (int r = 0; r < 16; ++r) { SA[p][r] -= delta; SB[p][r] -= delta; }
            { const float nm = sa.negm[0] - delta;
#pragma unroll
              for (int r = 0; r < 16; ++r) sa.negm[r] = nm; }
        }
        sa.seen = sa.seen || valid;
    }
    bf16x8 vf[2][2][2];
#pragma unroll
    for (int p = 0; p < 2; ++p)
#pragma unroll
        for (int s = 0; s < 2; ++s)
#pragma unroll
            for (int db = 0; db < 2; ++db) vf[p][s][db] = vfrag(vbase + db * 4096 + p * 2048 + s * 1024);
    f32x2 ra = (f32x2){0.f, 0.f}, rb = (f32x2){0.f, 0.f};
#pragma unroll
    for (int p = 0; p < 2; ++p)
#pragma unroll
        for (int r = 0; r < 16; r += 2) { const float e0 = fexp2(SA[p][r]), e1 = fexp2(SA[p][r + 1]); SA[p][r] = e0; SA[p][r + 1] = e1; ra += (f32x2){e0, e1}; }
#pragma unroll
    for (int p = 0; p < 2; ++p)
#pragma unroll
        for (int s = 0; s < 2; ++s) { const bf16x8 pa = pack_p(SA[p], s);
#pragma unroll
            for (int db = 0; db < 2; ++db) sa.o[db] = __builtin_amdgcn_mfma_f32_32x32x16_bf16(vf[p][s][db], pa, sa.o[db], 0, 0, 0); }
#pragma unroll
    for (int p = 0; p < 2; ++p)
#pragma unroll
        for (int r = 0; r < 16; r += 2) { const float e0 = fexp2(SB[p][r]), e1 = fexp2(SB[p][r + 1]); SB[p][r] = e0; SB[p][r + 1] = e1; rb += (f32x2){e0, e1}; }
#pragma unroll
    for (int p = 0; p < 2; ++p)
#pragma unroll
        for (int s = 0; s < 2; ++s) { const bf16x8 pa = pack_p(SB[p], s);
#pragma unroll
            for (int db = 0; db < 2; ++db) oB[db] = __builtin_amdgcn_mfma_f32_32x32x16_bf16(vf[p][s][db], pa, oB[db], 0, 0, 0); }
    sa.l += ra.x + ra.y; lB += rb.x + rb.y;
}

template <int MODE>
__device__ __forceinline__ void attn_unit(const Ctx& c, int l, int b, int hd, int qblk) {
    int lane = c.lane; asm volatile("" : "+v"(lane));
    const int wid = c.wid, r32 = lane & 31, hi = lane >> 5;
    const bf16_t* Z = WSP(bf16_t, OFF_Z);
    const size_t rowb = (size_t)b * SEQ;
    int head, t0, NT, kpitch; const bf16_t *Qp, *Kp, *Vp; int ocol;
    if (MODE == 0) { head = hd; t0 = qblk * 256 + wid * 32; NT = 4 * (qblk + 1); Qp = Z + 0 + head * 64; Kp = Z + rowb * ZP + 256 + head * 64; Vp = Z + rowb * ZP + 512 + head * 64; kpitch = ZP; ocol = 0 + head * 64; }
    else if (MODE == 1) { head = wid & 3; t0 = qblk * 64 + (wid >> 2) * 32; NT = qblk + 1; Qp = Z + 768 + head * 64; Kp = Z + rowb * ZP + 2304; Vp = Z + rowb * ZP + 2368; kpitch = ZP; ocol = 256 + head * 64; }
    else if (MODE == 2) { head = hd; t0 = qblk * 256 + wid * 32; NT = 4 * (qblk + 1); Qp = Z + 1280 + head * 64; Kp = Z + rowb * ZP + 1536 + head * 64; Vp = Z + rowb * ZP + 1792 + head * 64; kpitch = ZP; ocol = 512 + head * 64; }
    else { head = hd; t0 = qblk * 256 + wid * 32; NT = 4; Qp = Z + 2048 + head * 64; const bf16_t* kv = WSP(bf16_t, OFF_MEMKV) + ((size_t)l * 2048 + (size_t)b * MEML) * 512; Kp = kv + head * 64; Vp = kv + 256 + head * 64; kpitch = 512; ocol = 768 + head * 64; }
    const int tq = t0 + r32;
    const size_t qtok = rowb + tq;
    float cq = 0.f;
    if (MODE == 0) cq = WSP(float, OFF_CUM)[((size_t)b * 4 + head) * SEQ + tq];
    const int krow = 8 * wid + (lane >> 3), kch = (lane & 7) ^ ((krow >> 1) & 7);
    const bf16_t* kg = Kp + (size_t)krow * kpitch + kch * 8;
    const bf16_t* vg = Vp + (size_t)(16 * (wid & 3) + (lane >> 2)) * kpitch + (wid >> 2) * 32 + (lane & 3) * 8;
    const float* cg = WSP(float, OFF_CUM) + ((size_t)b * 4 + head) * SEQ + 4 * lane;
    const unsigned* mg = WSP(unsigned, OFF_MASK) + (rowb + (size_t)qblk * 64 + lane) * 128;
    const int nops = ((MODE == 0 && wid == 0) || (MODE == 1 && wid == 1)) ? 3 : 2;
    const size_t tstep = (size_t)64 * kpitch;
    const unsigned lds0 = (unsigned)(uintptr_t)c.lds;
    const bf16_t* kgn = kg; const bf16_t* vgn = vg; const float* cgn = cg;
#define ATT_ISSUE(J, SL) do { \
        glds16(kgn, (unsigned)__builtin_amdgcn_readfirstlane(lds0 + (SL) * ATT_SLOT + wid * 1024)); kgn += tstep; \
        glds16(vgn, (unsigned)__builtin_amdgcn_readfirstlane(lds0 + (SL) * ATT_SLOT + 8192 + wid * 1024)); vgn += tstep; \
        if (MODE == 0 && wid == 0) { glds16(cgn, (unsigned)__builtin_amdgcn_readfirstlane(lds0 + (SL) * ATT_SLOT + 16384)); cgn += 64; } \
        if (MODE == 1 && wid == 1) glds16(mg + 4 * ((J) >> 1), (unsigned)__builtin_amdgcn_readfirstlane(lds0 + (SL) * ATT_SLOT + 16384)); } while (0)
#define ATT_STEP(J, SL) do { const int j_ = (J); const int ah_ = (NT - 1 - j_) < 2 ? (NT - 1 - j_) : 2; ATT_WAIT_BAR(nops * ah_); \
        if (j_ + 3 < NT) ATT_ISSUE(j_ + 3, ((SL) + 3) & 3); \
        if ((MODE == 3) || (64 * j_ <= t0 + 31)) { if constexpr (MODE == 2) att_tile2<SL>(c.lds, j_, qf, sa, o1, lB, t0, tq, r32, hi, vb); else att_tile<MODE, SL, NQS>(c.lds, j_, mp, qf, sa, t0, tq, r32, hi, vb, mq, cq); } } while (0)
    const int vb = (4 * hi + ((lane & 15) >> 2)) * 64 + ((lane >> 4) & 1) * 32 + (lane & 3) * 8;
    const int mq = (MODE == 1) ? ((wid >> 2) * 32 + r32) : 0;
    constexpr int NMAP = 1;
    constexpr int NQS = 4;
    f32x16 o1[2]; o1[0] = (f32x16){}; o1[1] = (f32x16){}; float lB = 0.f;
    SoftState sa;
#pragma unroll 1
    for (int mp = 0; mp < NMAP; ++mp) {
        bf16x8 qf[NQS];
#pragma unroll
        for (int s = 0; s < NQS; ++s) qf[s] = *(const bf16x8*)(Qp + qtok * ZP + 16 * (NQS * mp + s) + 8 * hi);
#pragma unroll
        for (int s = 0; s < NQS; ++s) asm volatile("" : "+v"(qf[s]));
        asm volatile("" : "+v"(cq));
        soft_init(sa);
        ATT_ISSUE(0, 0); if (NT > 1) ATT_ISSUE(1, 1); if (NT > 2) ATT_ISSUE(2, 2);
#pragma unroll 1
        for (int j0 = 0; j0 < NT; j0 += 4) {
            ATT_STEP(j0, 0);
            if (j0 + 1 < NT) ATT_STEP(j0 + 1, 1);
            if (j0 + 2 < NT) ATT_STEP(j0 + 2, 2);
            if (j0 + 3 < NT) ATT_STEP(j0 + 3, 3);
        }
        asm volatile("s_waitcnt lgkmcnt(0)\n\ts_barrier" ::: "memory");
    }
#undef ATT_ISSUE
#undef ATT_STEP
    const float la = sa.l + __shfl_xor(sa.l, 32); const float ia = __builtin_amdgcn_rcpf(la);
    bf16_t* orow; int hi_e;
    {
        int ln_; asm volatile("v_mbcnt_lo_u32_b32 %0, -1, 0\n\tv_mbcnt_hi_u32_b32 %0, -1, %0" : "=v"(ln_));
        hi_e = ln_ >> 5;
        orow = WSP(bf16_t, OFF_O) + (size_t)(ocol >> 8) * T * 256 + (rowb + (size_t)(t0 + (ln_ & 31))) * 256 + (ocol & 255);
    }
    if (MODE != 2) {
#pragma unroll
        for (int db = 0; db < 2; ++db)
#pragma unroll
            for (int g2 = 0; g2 < 4; g2 += 2) {
                unsigned a0 = cvt_pk_bf16_c(sa.o[db][4 * g2] * ia, sa.o[db][4 * g2 + 1] * ia), a1 = cvt_pk_bf16_c(sa.o[db][4 * g2 + 2] * ia, sa.o[db][4 * g2 + 3] * ia);
                unsigned b0 = cvt_pk_bf16_c(sa.o[db][4 * g2 + 4] * ia, sa.o[db][4 * g2 + 5] * ia), b1 = cvt_pk_bf16_c(sa.o[db][4 * g2 + 6] * ia, sa.o[db][4 * g2 + 7] * ia);
                const auto s0 = __builtin_amdgcn_permlane32_swap(a0, b0, false, false); const auto s1 = __builtin_amdgcn_permlane32_swap(a1, b1, false, false);
                u32x4 w; w.x = s0[0]; w.y = s1[0]; w.z = s0[1]; w.w = s1[1];
                *(u32x4*)(orow + 32 * db + 8 * (g2 + hi_e)) = w; }
    } else {
        const float lam = WSP(float, OFF_MISC)[65536 + 2 * l], oml = WSP(float, OFF_MISC)[65536 + 2 * l + 1];
        const float lb2 = lB + __shfl_xor(lB, 32); const float iab = __builtin_amdgcn_rcpf(lb2);
        float ss = 0.f;
#pragma unroll
        for (int db = 0; db < 2; ++db)
#pragma unroll
            for (int r = 0; r < 16; ++r) { const float v = sa.o[db][r] * ia - lam * (o1[db][r] * iab); o1[db][r] = v; ss += v * v; }
        ss += __shfl_xor(ss, 32);
        const float rstd = __builtin_amdgcn_rsqf(ss * (1.0f / 64.0f) + EPS) * oml;
        const float* sg = c.diff_subln_g + l * 64;
#pragma unroll
        for (int db = 0; db < 2; ++db)
#pragma unroll
            for (int g2 = 0; g2 < 4; g2 += 2) { unsigned pk[2][2];
#pragma unroll
                for (int k = 0; k < 2; ++k) { const int gq = g2 + k, d = 32 * db + 8 * gq + 4 * hi_e; const f32x4 gg = *(const f32x4*)(sg + d);
                    pk[k][0] = cvt_pk_bf16_c(o1[db][4 * gq] * rstd * gg.x, o1[db][4 * gq + 1] * rstd * gg.y); pk[k][1] = cvt_pk_bf16_c(o1[db][4 * gq + 2] * rstd * gg.z, o1[db][4 * gq + 3] * rstd * gg.w); }
                const auto s0 = __builtin_amdgcn_permlane32_swap(pk[0][0], pk[1][0], false, false); const auto s1 = __builtin_amdgcn_permlane32_swap(pk[0][1], pk[1][1], false, false);
                u32x4 w; w.x = s0[0]; w.y = s1[0]; w.z = s0[1]; w.w = s1[1];
                *(u32x4*)(orow + 32 * db + 8 * (g2 + hi_e)) = w; }
    }
}
constexpr int ATT_BUF = 16640;

template <int MODE>
__device__ __forceinline__ void attn_unit_rs(const Ctx& c, int l, int b, int hd, int qblk) {
    const int lane = c.lane, wid = c.wid, r32 = lane & 31, hi = lane >> 5, tid = c.tid;
    const bf16_t* Z = WSP(bf16_t, OFF_Z);
    const size_t rowb = (size_t)b * SEQ;
    int head, t0, NT, kpitch; const bf16_t *Qp, *Kp, *Vp; int ocol;
    if (MODE == 0) { head = hd; t0 = qblk * 256 + wid * 32; NT = 4 * (qblk + 1); Qp = Z + 0 + head * 64; Kp = Z + rowb * ZP + 256 + head * 64; Vp = Z + rowb * ZP + 512 + head * 64; kpitch = ZP; ocol = 0 + head * 64; }
    else if (MODE == 1) { head = wid & 3; t0 = qblk * 64 + (wid >> 2) * 32; NT = qblk + 1; Qp = Z + 768 + head * 64; Kp = Z + rowb * ZP + 2304; Vp = Z + rowb * ZP + 2368; kpitch = ZP; ocol = 256 + head * 64; }
    else if (MODE == 2) { head = hd; t0 = qblk * 256 + wid * 32; NT = 4 * (qblk + 1); Qp = Z + 1280 + head * 64; Kp = Z + rowb * ZP + 1536 + head * 64; Vp = Z + rowb * ZP + 1792 + head * 64; kpitch = ZP; ocol = 512 + head * 64; }
    else { head = hd; t0 = qblk * 256 + wid * 32; NT = 4; Qp = Z + 2048 + head * 64; const bf16_t* kv = WSP(bf16_t, OFF_MEMKV) + ((size_t)l * 2048 + (size_t)b * MEML) * 512; Kp = kv + head * 64; Vp = kv + 256 + head * 64; kpitch = 512; ocol = 768 + head * 64; }
    const int tq = t0 + r32;
    const size_t qtok = rowb + tq;
    float cq = 0.f;
    if (MODE == 0) cq = WSP(float, OFF_CUM)[((size_t)b * 4 + head) * SEQ + tq];
    const unsigned* mrow = WSP(unsigned, OFF_MASK) + qtok * 128;
    const int srow = tid >> 3, sch = tid & 7;
    const int koff = sw_off(srow, sch), voff = 8192 + (sch >> 2) * 4096 + srow * 64 + (sch & 3) * 16;
    const bf16_t* kg = Kp + (size_t)srow * kpitch + sch * 8; const bf16_t* vg = Vp + (size_t)srow * kpitch + sch * 8;
    const float* cg = WSP(float, OFF_CUM) + ((size_t)b * 4 + head) * SEQ + (tid & 63);
    const int vb = (4 * hi + ((lane & 15) >> 2)) * 64 + ((lane >> 4) & 1) * 32 + (lane & 3) * 8;
    constexpr int NMAP = (MODE == 2) ? 2 : 1;
    constexpr int NQS = (MODE == 2) ? 2 : 4;
    f32x16 o1[2]; o1[0] = (f32x16){}; o1[1] = (f32x16){};
    SoftState sa;
#pragma unroll 1
    for (int mp = 0; mp < NMAP; ++mp) {
        bf16x8 qf[NQS];
#pragma unroll
        for (int s = 0; s < NQS; ++s) qf[s] = *(const bf16x8*)(Qp + qtok * ZP + 16 * (NQS * mp + s) + 8 * hi);
        soft_init(sa);
        u32x4 rk = *(const u32x4*)kg, rv = *(const u32x4*)vg; float rc = 0.f;
        if (MODE == 0 && tid < 64) rc = cg[0];
        *(LAS u32x4*)(c.lds + koff) = rk; *(LAS u32x4*)(c.lds + voff) = rv; if (MODE == 0 && tid < 64) *(LAS float*)(c.lds + 16384 + tid * 4) = rc;
        __syncthreads();
#pragma unroll 1
        for (int j = 0; j < NT; ++j) {
            const int cur = (j & 1) * ATT_BUF, nxt = ATT_BUF - cur;
            const bool more = j + 1 < NT;
            if (more) { const size_t ro = (size_t)(j + 1) * 64 * kpitch; rk = *(const u32x4*)(kg + ro); rv = *(const u32x4*)(vg + ro); if (MODE == 0 && tid < 64) rc = cg[(size_t)(j + 1) * 64]; }
            const bool active = (MODE == 3) || (64 * j <= t0 + 31);
            if (active) {
                const LAS unsigned char* kb = c.lds + cur; const LAS unsigned char* vbase = c.lds + cur + 8192 + vb;
                u32x2 mw = (u32x2){0u, 0u};
                if (MODE == 1) mw = *(const u32x2*)(mrow + 2 * j);
                f32x16 S[2]; S[0] = (f32x16){}; S[1] = (f32x16){};
                if (MODE == 0) {
#pragma unroll
                    for (int p = 0; p < 2; ++p)
#pragma unroll
                        for (int gq = 0; gq < 4; ++gq) { const f32x4 ck = *(const LAS f32x4*)(c.lds + cur + 16384 + (32 * p + 8 * gq + 4 * hi) * 4);
#pragma unroll
                            for (int i = 0; i < 4; ++i) S[p][4 * gq + i] = (cq + sa.negm[0]) - ck[i]; }
                }
                {
                    bf16x8 kf[NQS][2];
#pragma unroll
                    for (int s = 0; s < NQS; ++s)
#pragma unroll
                        for (int p = 0; p < 2; ++p) kf[s][p] = *(const LAS bf16x8*)(kb + sw_off(32 * p + r32, 2 * (NQS * mp + s) + hi));
#pragma unroll
                    for (int s = 0; s < NQS; ++s)
#pragma unroll
                        for (int p = 0; p < 2; ++p) S[p] = __builtin_amdgcn_mfma_f32_32x32x16_bf16(kf[s][p], qf[s], (s == 0 && MODE != 0) ? sa.negm : S[p], 0, 0, 0);
                }
                constexpr bool VPRE = true;
                bf16x8 vf[2][2][2];
                if (VPRE) {
#pragma unroll
                    for (int p = 0; p < 2; ++p)
#pragma unroll
                        for (int s = 0; s < 2; ++s)
#pragma unroll
                            for (int db = 0; db < 2; ++db) vf[p][s][db] = vfrag(vbase + db * 4096 + p * 2048 + s * 1024);
                }
                if (MODE == 0 || MODE == 2) {
                    if (64 * j + 63 > t0) {
#pragma unroll
                        for (int p = 0; p < 2; ++p)
#pragma unroll
                            for (int r = 0; r < 16; ++r) { const int kv = 64 * j + 32 * p + crow(r, hi); if (kv > tq) S[p][r] = -INFINITY; }
                    }
                }
                if (MODE == 1) {
#pragma unroll
                    for (int p = 0; p < 2; ++p) { const unsigned wsh = (p == 0 ? mw.x : mw.y) >> (4 * hi);
#pragma unroll
                        for (int r = 0; r < 16; ++r) { const unsigned t_ = (unsigned)__builtin_amdgcn_sbfe((int)wsh, (r & 3) + 8 * (r >> 2), 1);
                            S[p][r] = __uint_as_float((__float_as_uint(S[p][r]) & t_) | (0xFF800000u & ~t_)); } }
                }
                soft_update<true>(sa, S);
#pragma unroll
                for (int p = 0; p < 2; ++p)
#pragma unroll
                    for (int s = 0; s < 2; ++s) {
                        const bf16x8 pa = pack_p(S[p], s);
#pragma unroll
                        for (int db = 0; db < 2; ++db) { const bf16x8 vv = VPRE ? vf[p][s][db] : vfrag(vbase + db * 4096 + p * 2048 + s * 1024);
                            sa.o[db] = __builtin_amdgcn_mfma_f32_32x32x16_bf16(vv, pa, sa.o[db], 0, 0, 0); }
                    }
            }
            if (more) { *(LAS u32x4*)(c.lds + nxt + koff) = rk; *(LAS u32x4*)(c.lds + nxt + voff) = rv; if (MODE == 0 && tid < 64) *(LAS float*)(c.lds + nxt + 16384 + tid * 4) = rc; }
            __syncthreads();
        }
        if (MODE == 2 && mp == 0) {
            const float la = sa.l + __shfl_xor(sa.l, 32); const float ia = __builtin_amdgcn_rcpf(la);
#pragma unroll
            for (int db = 0; db < 2; ++db)
#pragma unroll
                for (int r = 0; r < 16; ++r) o1[db][r] = sa.o[db][r] * ia;
        }
    }
    const float la = sa.l + __shfl_xor(sa.l, 32); const float ia = __builtin_amdgcn_rcpf(la);
    bf16_t* orow = WSP(bf16_t, OFF_O) + (size_t)(ocol >> 8) * T * 256 + qtok * 256 + (ocol & 255);
    if (MODE != 2) {
#pragma unroll
        for (int db = 0; db < 2; ++db)
#pragma unroll
            for (int gq = 0; gq < 4; ++gq) { u32x2 w; w.x = cvt_pk_bf16(sa.o[db][4 * gq] * ia, sa.o[db][4 * gq + 1] * ia); w.y = cvt_pk_bf16(sa.o[db][4 * gq + 2] * ia, sa.o[db][4 * gq + 3] * ia);
                *(u32x2*)(orow + 32 * db + 8 * gq + 4 * hi) = w; }
    } else {
        const float lam = WSP(float, OFF_MISC)[65536 + 2 * l], oml = WSP(float, OFF_MISC)[65536 + 2 * l + 1];
        float ss = 0.f;
#pragma unroll
        for (int db = 0; db < 2; ++db)
#pragma unroll
            for (int r = 0; r < 16; ++r) { const float v = o1[db][r] - lam * (sa.o[db][r] * ia); o1[db][r] = v; ss += v * v; }
        ss += __shfl_xor(ss, 32);
        const float rstd = __builtin_amdgcn_rsqf(ss * (1.0f / 64.0f) + EPS) * oml;
        const float* sg = c.diff_subln_g + l * 64;
#pragma unroll
        for (int db = 0; db < 2; ++db)
#pragma unroll
            for (int gq = 0; gq < 4; ++gq) { const int d = 32 * db + 8 * gq + 4 * hi; const f32x4 gg = *(const f32x4*)(sg + d);
                u32x2 w; w.x = cvt_pk_bf16(o1[db][4 * gq] * rstd * gg.x, o1[db][4 * gq + 1] * rstd * gg.y); w.y = cvt_pk_bf16(o1[db][4 * gq + 2] * rstd * gg.z, o1[db][4 * gq + 3] * rstd * gg.w);
                *(u32x2*)(orow + d) = w; }
    }
}
__device__ __forceinline__ void p3_units(const Ctx& c0, int l, int qo = 0) {
    PHASE_CTX(c0);
    const int grp = c.blk & 7, jg = c.blk >> 3, nper = (c.nblk - grp + 7) >> 3;
    (void)qo;
#define P3_KIND(...) _Pragma("unroll 1") for (int f = jg; f < 32; f += nper) { _Pragma("unroll 1") for (int h2 = 0; h2 < 2; ++h2) { const int u = h2 ? 63 - f : f; __VA_ARGS__ } }
    P3_KIND({ const int bh = grp + 8 * (u & 3), qk = 15 - (u >> 2); if (ATT_DMA_MODES & 4) attn_unit<2>(c, l, bh >> 2, bh & 3, qk); else attn_unit_rs<2>(c, l, bh >> 2, bh & 3, qk); })
    P3_KIND({ const int bh = grp + 8 * (u & 3), qk = 15 - (u >> 2); if (ATT_DMA_MODES & 1) attn_unit<0>(c, l, bh >> 2, bh & 3, qk); else attn_unit_rs<0>(c, l, bh >> 2, bh & 3, qk); })
    P3_KIND({ if (ATT_DMA_MODES & 2) attn_unit<1>(c, l, grp, 0, 63 - u); else attn_unit_rs<1>(c, l, grp, 0, 63 - u); })
    P3_KIND({ const int bh = grp + 8 * (u & 3), qk = u >> 2; if (ATT_DMA_MODES & 8) attn_unit<3>(c, l, bh >> 2, bh & 3, qk); else attn_unit_rs<3>(c, l, bh >> 2, bh & 3, qk); })
#undef P3_KIND
}

__device__ __forceinline__ bf16_t* y_row(unsigned char* ws, float* dout, size_t tok) {
    return tok < (size_t)(T / 2) ? (bf16_t*)(ws + OFF_Z) + tok * 4096 : (bf16_t*)dout + (tok - T / 2) * 4096;
}
struct YOrder {
    int G, c;
    __device__ __forceinline__ bool next(int i, pg8::Unit& u) const { const int L = i * G + c; if (L >= 2048) return false; const int n = L >> 9, rem = L & 511; u.pm = n * 128 + (rem >> 2); u.pn = n * 4 + (rem & 3); return true; }
    __device__ __forceinline__ void a_ready(const pg8::Unit&) const {}
    __device__ __forceinline__ void done(const pg8::Unit&) const {}
};
struct EpiY {
    static constexpr bool PERM = false, AFTER_DRAIN = false;
    unsigned char* ws; float* dout;
    __device__ __forceinline__ void operator()(const f32x4 (&acc)[2][2][4][2], const pg8::Unit& u, int wr, int wc, int fr, int fq) const {
        { int ln_; asm volatile("v_mbcnt_lo_u32_b32 %0, -1, 0\n\tv_mbcnt_hi_u32_b32 %0, -1, %0" : "=v"(ln_)); fr = ln_ & 15; fq = ln_ >> 4; }
        const int n = u.pn >> 2, pnl = u.pn & 3, tt = u.pm - n * 128;
#pragma unroll
        for (int ai = 0; ai < 2; ++ai)
#pragma unroll
            for (int m = 0; m < 4; ++m) {
                const size_t tok = (size_t)tt * 256 + ai * 128 + wr * 64 + m * 16 + fr;
                bf16_t* yr = y_row(ws, dout, tok) + n * DM + pnl * 256 + wc * 32 + ((fq & 1) ? 16 + 4 * (fq - 1) : 4 * fq);
#pragma unroll
                for (int bj = 0; bj < 2; ++bj) { const f32x4 v0 = acc[ai][bj][m][0], v1 = acc[ai][bj][m][1];
                    unsigned a0 = cvt_pk_bf16(v0.x, v0.y), a1 = cvt_pk_bf16(v0.z, v0.w), b0 = cvt_pk_bf16(v1.x, v1.y), b1 = cvt_pk_bf16(v1.z, v1.w);
                    asm volatile("s_nop 1" : "+v"(a0), "+v"(a1), "+v"(b0), "+v"(b1));
                    const auto s0 = __builtin_amdgcn_permlane16_swap(a0, b0, false, false);
                    const auto s1 = __builtin_amdgcn_permlane16_swap(a1, b1, false, false);
                    u32x4 w; w.x = s0[0]; w.y = s1[0]; w.z = s0[1]; w.w = s1[1]; st16_wt(yr + bj * 128, w); }
            }
    }
};
__device__ __forceinline__ void p4a_units(const Ctx& c0) {
    PHASE_CTX(c0);
    pg8::Gemm g{WSP(bf16_t, OFF_O), WSP(bf16_t, OFF_WBT), 4 * T, 4096, 256}; YOrder S{c.nblk, c.blk};
    EpiY E{c.ws, c.out};
    pg8::gemm_phase<EpiY, YOrder, true, true>(c.lds, g, S, E, c.tid);
}
struct EpiGM {
    static constexpr bool PERM = false, AFTER_DRAIN = false;
    unsigned char* ws; float* dout; const float* bgate; const float* ss;
    __device__ __forceinline__ void operator()(const f32x4 (&acc)[2][2][4][2], const pg8::Unit& u, int wr, int wc, int fr, int fq) const {
        { int ln_; asm volatile("v_mbcnt_lo_u32_b32 %0, -1, 0\n\tv_mbcnt_hi_u32_b32 %0, -1, %0" : "=v"(ln_)); fr = ln_ & 15; fq = ln_ >> 4; }
        const int d4 = 64 * u.pn + 16 * wc + 4 * fq;
        f32x4 bg[4];
#pragma unroll
        for (int br = 0; br < 4; ++br) bg[br] = *(const f32x4*)(bgate + br * DM + d4);
        float rs8[2][4]; u32x2 yv[2][4][4];
#pragma unroll
        for (int ai = 0; ai < 2; ++ai)
#pragma unroll
            for (int m = 0; m < 4; ++m) {
                const size_t tok = (size_t)u.pm * 256 + ai * 128 + wr * 64 + m * 16 + fr;
                rs8[ai][m] = rs_row_coop(ss, tok, fq);
                const bf16_t* yr = y_row(ws, dout, tok) + d4;
#pragma unroll
                for (int br = 0; br < 4; ++br) yv[ai][m][br] = *(const u32x2*)(yr + br * DM);
            }
#pragma unroll
        for (int ai = 0; ai < 2; ++ai)
#pragma unroll
            for (int m2 = 0; m2 < 4; m2 += 2) {
                u32x2 wm[2];
#pragma unroll
                for (int mm = 0; mm < 2; ++mm) { const int m = m2 + mm;
                    const float rs = rs8[ai][m];
                    f32x4 o = (f32x4){0.f, 0.f, 0.f, 0.f};
#pragma unroll
                    for (int br = 0; br < 4; ++br) { const f32x4 a = acc[ai][br >> 1][m][br & 1];
#pragma unroll
                        for (int i = 0; i < 4; ++i) { const float z = a[i] * rs + bg[br][i]; const float gt = __builtin_amdgcn_rcpf(1.0f + fexp2(-LOG2E * z));
                            const unsigned w = (i >> 1) ? yv[ai][m][br].y : yv[ai][m][br].x; const float yf = __uint_as_float((i & 1) ? (w & 0xffff0000u) : (w << 16)); o[i] += gt * yf; } }
                    wm[mm].x = cvt_pk_bf16(o.x, o.y); wm[mm].y = cvt_pk_bf16(o.z, o.w); }
                asm volatile("s_nop 1" : "+v"(wm[0].x), "+v"(wm[0].y), "+v"(wm[1].x), "+v"(wm[1].y));
                const auto s0 = __builtin_amdgcn_permlane16_swap(wm[0].x, wm[1].x, false, false);
                const auto s1 = __builtin_amdgcn_permlane16_swap(wm[0].y, wm[1].y, false, false);
                u32x4 w; w.x = s0[0]; w.y = s1[0]; w.z = s0[1]; w.w = s1[1];
                const size_t tok = (size_t)u.pm * 256 + ai * 128 + wr * 64 + (m2 + (fq & 1)) * 16 + fr;
                st16_wt((bf16_t*)(ws + OFF_MRG) + tok * DM + 64 * u.pn + 16 * wc + 4 * (fq & 2), w);
            }
    }
};
__device__ __forceinline__ void p4b_units(const Ctx& c0, int l) {
    PHASE_CTX(c0);
    pg8::Gemm g{WSP(bf16_t, OFF_XB), WSP(bf16_t, OFF_WGT), T, 4096, DM}; pg8::StaticOrder S; S.init(T, 4096, c.nblk, c.blk);
    EpiGM E{c.ws, c.out, c.b_gate + (size_t)l * 4096, WSP(float, OFF_SS) + ss_off(2 * l)};
    pg8::gemm_phase<EpiGM, pg8::StaticOrder, true, true>(c.lds, g, S, E, c.tid);
}

struct EpiRes {
    static constexpr bool PERM = false, AFTER_DRAIN = false;
    const float* basef; float* Xout; bf16_t* XB; float* ss;
    __device__ __forceinline__ void operator()(const f32x4 (&acc)[2][2][4][2], const pg8::Unit& u, int wr, int wc, int fr, int fq) const {
        { int ln_; asm volatile("v_mbcnt_lo_u32_b32 %0, -1, 0\n\tv_mbcnt_hi_u32_b32 %0, -1, %0" : "=v"(ln_)); fr = ln_ & 15; fq = ln_ >> 4; }
#pragma unroll
        for (int ai = 0; ai < 2; ++ai) {
            f32x4 pre[4][2][2];
            if (basef) {
#pragma unroll
                for (int m = 0; m < 4; ++m) { const size_t tok = (size_t)u.pm * 256 + ai * 128 + wr * 64 + m * 16 + fr;
#pragma unroll
                    for (int bj = 0; bj < 2; ++bj)
#pragma unroll
                        for (int n = 0; n < 2; ++n) pre[m][bj][n] = *(const f32x4*)(basef + tok * DM + u.pn * 256 + bj * 128 + wc * 32 + n * 16 + 4 * fq); }
            } else {
                u32x2 pb[4][2][2];
#pragma unroll
                for (int m = 0; m < 4; ++m) { const size_t tok = (size_t)u.pm * 256 + ai * 128 + wr * 64 + m * 16 + fr;
#pragma unroll
                    for (int bj = 0; bj < 2; ++bj)
#pragma unroll
                        for (int n = 0; n < 2; ++n) pb[m][bj][n] = *(const u32x2*)(XB + tok * DM + u.pn * 256 + bj * 128 + wc * 32 + n * 16 + 4 * fq); }
#pragma unroll
                for (int m = 0; m < 4; ++m)
#pragma unroll
                    for (int bj = 0; bj < 2; ++bj)
#pragma unroll
                        for (int n = 0; n < 2; ++n) { const u32x2 w = pb[m][bj][n];
                            pre[m][bj][n] = (f32x4){__uint_as_float(w.x << 16), __uint_as_float(w.x & 0xffff0000u), __uint_as_float(w.y << 16), __uint_as_float(w.y & 0xffff0000u)}; }
            }
#pragma unroll
            for (int m = 0; m < 4; ++m) {
                const size_t tok = (size_t)u.pm * 256 + ai * 128 + wr * 64 + m * 16 + fr;
                float sq = 0.f;
#pragma unroll
                for (int bj = 0; bj < 2; ++bj) {
                    unsigned pk[2][2];
#pragma unroll
                    for (int n = 0; n < 2; ++n) { const size_t off = tok * DM + u.pn * 256 + bj * 128 + wc * 32 + n * 16 + 4 * fq;
                        const f32x4 o = pre[m][bj][n] + acc[ai][bj][m][n];
                        if (Xout) *(f32x4*)(Xout + off) = o;
                        pk[n][0] = cvt_pk_bf16(o.x, o.y); pk[n][1] = cvt_pk_bf16(o.z, o.w);
                        sq += (o.x * o.x + o.y * o.y) + (o.z * o.z + o.w * o.w); }
                    asm volatile("s_nop 1" : "+v"(pk[0][0]), "+v"(pk[0][1]), "+v"(pk[1][0]), "+v"(pk[1][1]));
                    const auto s0 = __builtin_amdgcn_permlane16_swap(pk[0][0], pk[1][0], false, false);
                    const auto s1 = __builtin_amdgcn_permlane16_swap(pk[0][1], pk[1][1], false, false);
                    u32x4 w; w.x = s0[0]; w.y = s1[0]; w.z = s0[1]; w.w = s1[1];
                    st16_wt(XB + tok * DM + u.pn * 256 + bj * 128 + wc * 32 + ((fq & 1) ? 16 + 4 * (fq - 1) : 4 * fq), w); }
                sq += __shfl_xor(sq, 16); sq += __shfl_xor(sq, 32);
                if (fq == 0) ss[tok * 16 + u.pn * 4 + wc] = sq;
            }
        }
    }
};
__device__ __forceinline__ void resid_gemm(const Ctx& c0, const bf16_t* A, int K, const bf16_t* Bt, bool from_input, bool write_x, int ssidx) {
    PHASE_CTX(c0);
    pg8::Gemm g{A, Bt, T, DM, K}; pg8::StaticOrder S; S.init(T, DM, c.nblk, c.blk);
    EpiRes E{from_input ? c.x : (const float*)nullptr, write_x ? WSP(float, OFF_X) : (float*)nullptr, WSP(bf16_t, OFF_XB), WSP(float, OFF_SS) + ss_off(ssidx)};
    pg8::gemm_phase<EpiRes, pg8::StaticOrder, true, true>(c.lds, g, S, E, c.tid);
}
struct EpiSw {
    static constexpr bool PERM = true, AFTER_DRAIN = false;
    bf16_t* AF; const float* ss;
    __device__ __forceinline__ void operator()(const f32x4 (&acc)[2][2][4][2], const pg8::Unit& u, int wr, int wc, int fr, int fq) const {
        { int ln_; asm volatile("v_mbcnt_lo_u32_b32 %0, -1, 0\n\tv_mbcnt_hi_u32_b32 %0, -1, %0" : "=v"(ln_)); fr = ln_ & 15; fq = ln_ >> 4; }
        float rs8[2][4];
#pragma unroll
        for (int ai = 0; ai < 2; ++ai)
#pragma unroll
            for (int m = 0; m < 4; ++m) rs8[ai][m] = rs_row_coop(ss, (size_t)u.pm * 256 + ai * 128 + wr * 64 + m * 16 + fr, fq);
#pragma unroll
        for (int ai = 0; ai < 2; ++ai)
#pragma unroll
            for (int m = 0; m < 4; ++m) {
                const size_t tok = (size_t)u.pm * 256 + ai * 128 + wr * 64 + m * 16 + fr;
                const float rs = rs8[ai][m], rsl = -LOG2E * rs;
                u32x4 w;
#pragma unroll
                for (int n = 0; n < 2; ++n) { f32x4 o;
#pragma unroll
                    for (int i = 0; i < 4; ++i) { const float ga = acc[ai][0][m][n][i], ua = acc[ai][1][m][n][i]; o[i] = (ga * rs) * __builtin_amdgcn_rcpf(1.0f + fexp2(ga * rsl)) * (ua * rs); }
                    if (n == 0) { w.x = cvt_pk_bf16(o.x, o.y); w.y = cvt_pk_bf16(o.z, o.w); } else { w.z = cvt_pk_bf16(o.x, o.y); w.w = cvt_pk_bf16(o.z, o.w); } }
                st16_wt(AF + tok * FF + u.pn * 128 + wc * 32 + 8 * fq, w);
            }
    }
};
__device__ __forceinline__ void p6_units(const Ctx& c0, int l) {
    PHASE_CTX(c0);
    pg8::Gemm g{WSP(bf16_t, OFF_XB), WSP(bf16_t, OFF_WF1T), T, 2 * FF, DM}; pg8::StaticOrder S; S.init(T, 2 * FF, c.nblk, c.blk);
    EpiSw E{WSP(bf16_t, OFF_AF), WSP(float, OFF_SS) + ss_off(2 * l + 1)};
    pg8::gemm_phase<EpiSw, pg8::StaticOrder, true, true>(c.lds, g, S, E, c.tid);
}

constexpr int NSTEP = 2 + 8 * DEPTH;
__global__ void __launch_bounds__(NTHREADS, 2) trunk_fwd(Params p) {
    extern __shared__ __attribute__((aligned(16))) unsigned char lds_raw[];
    Ctx c;
    c.x = nullptr; c.mem = nullptr; c.pos = nullptr; c.norm_mix_g = nullptr; c.w_in = nullptr; c.b_forget = nullptr; c.diff_lambda = nullptr; c.diff_subln_g = nullptr; c.norm_mem_g = nullptr; c.w_mem_kv = nullptr;
    c.w_branch = nullptr; c.w_gate = nullptr; c.b_gate = nullptr; c.w_out = nullptr; c.norm_ffn_g = nullptr; c.w_ffn_in = nullptr; c.w_ffn_out = nullptr; c.final_norm_g = nullptr;
    c.out = nullptr; c.ws = p.ws; c.lds = (LAS unsigned char*)lds_raw; c.tid = threadIdx.x; c.lane = c.tid & 63; c.wid = __builtin_amdgcn_readfirstlane(c.tid >> 6);
    c.nblk = gridDim.x; c.blk = blockIdx.x;
    if (c.tid < 64) ((LAS unsigned*)(c.lds + LDS_CTL))[c.tid] = 0u;
    __syncthreads();
    XcdBarrier bar; bar.bar = WSP(unsigned, OFF_CTL) + CW_BAR; bar.x = 0; bar.st = nullptr;
    const bool multi = (p.s_hi - p.s_lo) > 1;
    if (multi) bar = xcd_barrier_post(WSP(unsigned, OFF_CTL) + CW_BAR, (volatile LAS unsigned*)(c.lds + LDS_CTL));
#define STEP_ON(s) (p.s_lo <= (s) && (s) < p.s_hi)
#define STEP_SYNC(s) do { if ((s) + 1 < p.s_hi) xcd_barrier(bar, c.wid); } while (0)
    if (STEP_ON(0)) { prologue(c); STEP_SYNC(0); }
    for (int l = 0; l < DEPTH; ++l) {
        const int sb = 1 + 8 * l;
        if (STEP_ON(sb + 0)) { p1_units(c, l); STEP_SYNC(sb + 0); }
        if (STEP_ON(sb + 1)) {
_Pragma("unroll 1") for (int rep = 0; rep < (PROBE_DUP == 2 ? 2 : 1); ++rep) p2_units(c, l, 8 * rep);
 if (l > 0) prep_ffn(c, l); STEP_SYNC(sb + 1); }
        if (STEP_ON(sb + 2)) {
_Pragma("unroll 1") for (int rep = 0; rep < (PROBE_DUP == 3 ? 2 : 1); ++rep) p3_units(c, l, 8 * rep);
 STEP_SYNC(sb + 2); }
        if (STEP_ON(sb + 3)) {
_Pragma("unroll 1") for (int rep = 0; rep < (PROBE_DUP == 4 ? 2 : 1); ++rep) p4a_units(c);
 STEP_SYNC(sb + 3); }
        if (STEP_ON(sb + 4)) {
_Pragma("unroll 1") for (int rep = 0; rep < (PROBE_DUP == 5 ? 2 : 1); ++rep) p4b_units(c, l);
 STEP_SYNC(sb + 4); }
        if (STEP_ON(sb + 5)) { resid_gemm(c, WSP(bf16_t, OFF_MRG), DM, WSP(bf16_t, OFF_WOT), l == 0, false, 2 * l + 1); STEP_SYNC(sb + 5); }
        if (STEP_ON(sb + 6)) {
_Pragma("unroll 1") for (int rep = 0; rep < (PROBE_DUP == 6 ? 2 : 1); ++rep) p6_units(c, l);
 if (l + 1 < DEPTH) prep_mixer(c, l + 1);
 STEP_SYNC(sb + 6); }
        if (STEP_ON(sb + 7)) { resid_gemm(c, WSP(bf16_t, OFF_AF), FF, WSP(bf16_t, OFF_WF2T), false, l == DEPTH - 1, 2 * l + 2); STEP_SYNC(sb + 7); }
    }
    if (STEP_ON(NSTEP - 1)) final_norm(c);
}

extern "C" void kernel_launch(void* const* d_in, const int* in_sizes, int n_in, void* d_out, int out_size, void* d_ws, size_t ws_size, hipStream_t stream) {
    static int grid = 0;
    if (grid == 0) {
        if (n_in != 18 || out_size != T * DM || ws_size < WS_END) { fprintf(stderr, "kernel_launch: unexpected shapes (n_in %d out %d ws %zu)\n", n_in, out_size, ws_size); grid = -1; return; }
        int dev = 0, cus = 0, per_cu = 0;
        if (hipGetDevice(&dev) != hipSuccess || hipDeviceGetAttribute(&cus, hipDeviceAttributeMultiprocessorCount, dev) != hipSuccess) { grid = -1; return; }
        if (hipFuncSetAttribute((const void*)trunk_fwd, hipFuncAttributeMaxDynamicSharedMemorySize, LDS_BYTES) != hipSuccess) { grid = -1; return; }
        if (hipOccupancyMaxActiveBlocksPerMultiprocessor(&per_cu, (const void*)trunk_fwd, NTHREADS, LDS_BYTES) != hipSuccess || per_cu < 1) { fprintf(stderr, "kernel_launch: occupancy query says %d\n", per_cu); }
        (void)hipGetLastError();
        grid = cus;
    }
    if (grid < 0) return;
    (void)hipMemsetAsync((char*)d_ws + OFF_CTL, 0, ZERO_BYTES, stream);
    Params p{};
    for (int i = 0; i < 18; ++i) p.in[i] = (const float*)d_in[i];
    p.out = (float*)d_out; p.ws = (unsigned char*)d_ws;
#if MK_ONE_LAUNCH
    p.s_lo = 0; p.s_hi = NSTEP;
    hipLaunchKernelGGL(trunk_fwd, dim3(grid), dim3(NTHREADS), LDS_BYTES, stream, p);
#else
    for (int s = 0; s < NSTEP; ++s) { p.s_lo = s; p.s_hi = s + 1; hipLaunchKernelGGL(trunk_fwd, dim3(grid), dim3(NTHREADS), LDS_BYTES, stream, p); }
#endif
}
```
